# Optimizing an MI355X kernel written in HIP

```python
import jax, jax.numpy as jnp
from jax import lax
import numpy as np

D_MODEL = 2048
BATCH = 4
SEQ = 2048
DEPTH = 1
DEC_BATCH = 128
DEC_SEQ = 1
PAST_LEN = 16384
PAGE_SIZE = 128

GLA_HEADS = 4
GLA_DK = D_MODEL // 2
GLA_DV = D_MODEL
GLA_HK = GLA_DK // GLA_HEADS
GLA_HV = GLA_DV // GLA_HEADS
GLA_RANK = 16
GLA_GATE_NORM = 16.0
GLA_CHUNK = 64
CONV_DIM = D_MODEL // 2
CONV_K = 3
N_MEM = 256
MEM_HEADS = 4
MEM_DIM = D_MODEL // 2
MEM_HD = MEM_DIM // MEM_HEADS
D_FF = ((8 * D_MODEL // 3) + 127) // 128 * 128
FFN_CONV_K = 3
DN_ALPHA = (2 * DEPTH) ** 0.25
DN_BETA = (8 * DEPTH) ** -0.25
LN_EPS = 1e-5
RMS_EPS = 1e-6
SPLITS = (GLA_DK, GLA_DK, GLA_DV, GLA_DV, GLA_RANK, CONV_DIM, CONV_DIM, CONV_DIM, MEM_DIM, D_MODEL, D_MODEL, D_MODEL)
IN_COLS = sum(SPLITS)
SPLIT_POINTS = tuple(int(s) for s in np.cumsum(SPLITS)[:-1])

kernel_name = 'hybrid_gla_shortconv_memxattn_deepnorm_step'


def _layer_norm(x, g, b):
    xf = x.astype(jnp.float32)
    mu = jnp.mean(xf, -1, keepdims=True)
    var = jnp.mean(jnp.square(xf - mu), -1, keepdims=True)
    y = (xf - mu) * lax.rsqrt(var + LN_EPS)
    return (y * g.astype(jnp.float32) + b.astype(jnp.float32)).astype(x.dtype)


def _causal_dwconv(u, buf, w, bias=None):
    K = w.shape[0]
    L = u.shape[1]
    z = jnp.concatenate([buf.astype(u.dtype), u], axis=1)
    y = z[:, 0:L] * w[0]
    for j in range(1, K):
        y = y + z[:, j:j + L] * w[j]
    if bias is not None:
        y = y + bias
    return y, z[:, L:]


def _gla_recurrence(q, k, v, log_a, s0):
    B, L, H, _ = q.shape
    c = min(GLA_CHUNK, L)
    n = -(-L // c)
    pad = n * c - L
    f32 = jnp.float32

    def chunks(t):
        t = jnp.pad(t.astype(f32), ((0, 0), (0, pad), (0, 0), (0, 0)))
        return t.reshape(B, n, c, H, t.shape[-1]).transpose(1, 0, 3, 2, 4)

    tri = jnp.tril(jnp.ones((c, c), dtype=bool))[:, :, None]

    def step(S, inp):
        qc, kc, vc, ac = inp
        bc = jnp.cumsum(ac, axis=2)
        diff = bc[:, :, :, None, :] - bc[:, :, None, :, :]
        decay = jnp.exp(jnp.where(tri, diff, -jnp.inf))
        scores = jnp.einsum('bhtk,bhsk,bhtsk->bhts', qc, kc, decay)
        o = (jnp.einsum('bhts,bhsv->bhtv', scores, vc)
             + jnp.einsum('bhtk,bhkv->bhtv', qc * jnp.exp(bc), S))
        b_last = bc[:, :, -1]
        S = (jnp.exp(b_last)[..., None] * S
             + jnp.einsum('bhsk,bhsv->bhkv', kc * jnp.exp(b_last[:, :, None] - bc), vc))
        return S, o

    s_fin, o = lax.scan(step, s0.astype(f32), (chunks(q), chunks(k), chunks(v), chunks(log_a)))
    o = o.transpose(1, 0, 3, 2, 4).reshape(B, n * c, H, -1)[:, :L]
    return o, s_fin


def _token_mixing(x, mem_k, mem_v, s_gla, s_conv, w_in, w_gla_a2, b_gla_a2, g_gla_norm, w_gla_out,
                  w_conv, w_conv_out, w_mem_out, w_o):
    B, L, _ = x.shape
    f32 = jnp.float32
    proj = jnp.einsum('bld,de->ble', x, w_in)
    q, k, v, g, a_lr, cb, cc, ch, mq, z_a, z_b, z_m = jnp.split(proj, SPLIT_POINTS, axis=-1)
    log_a = jax.nn.log_sigmoid((a_lr @ w_gla_a2 + b_gla_a2).astype(f32)) / GLA_GATE_NORM
    qh = q.reshape(B, L, GLA_HEADS, GLA_HK) * (GLA_HK ** -0.5)
    kh = k.reshape(B, L, GLA_HEADS, GLA_HK)
    vh = v.reshape(B, L, GLA_HEADS, GLA_HV)
    o, s_gla_new = _gla_recurrence(qh, kh, vh, log_a.reshape(B, L, GLA_HEADS, GLA_HK), s_gla)
    o = o * lax.rsqrt(jnp.mean(jnp.square(o), -1, keepdims=True) + RMS_EPS) * g_gla_norm.astype(f32)
    o = o.reshape(B, L, GLA_DV).astype(x.dtype) * jax.nn.silu(g)
    y_a = o @ w_gla_out
    u, s_conv_new = _causal_dwconv(cc * ch, s_conv, w_conv)
    y_b = (cb * u) @ w_conv_out
    qm = mq.reshape(B, L, MEM_HEADS, MEM_HD)
    logits = jnp.einsum('blhd,bmhd->bhlm', qm, mem_k).astype(f32) * (MEM_HD ** -0.5)
    p = jax.nn.softmax(logits, axis=-1).astype(x.dtype)
    om = jnp.einsum('bhlm,bmhd->blhd', p, mem_v).reshape(B, L, MEM_DIM).astype(x.dtype)
    y_m = om @ w_mem_out
    merged = jax.nn.sigmoid(z_a) * y_a + jax.nn.sigmoid(z_b) * y_b + jax.nn.sigmoid(z_m) * y_m
    return merged @ w_o, s_gla_new.astype(s_gla.dtype), s_conv_new


def _conv_ffn(x, s_ffn, w_ffn_gate, w_ffn_up, w_ffn_conv, b_ffn_conv, w_ffn_down):
    hg = x @ w_ffn_gate
    hu = x @ w_ffn_up
    hc, s_new = _causal_dwconv(hg, s_ffn, w_ffn_conv, b_ffn_conv)
    return (jax.nn.silu(hc) * hu) @ w_ffn_down, s_new


def _layer(x, mem_k, mem_v, s_gla, s_conv, s_ffn, lw):
    (w_in, w_gla_a2, b_gla_a2, g_gla_norm, w_gla_out, w_conv, w_conv_out, w_mem_out, w_o,
     ln1_g, ln1_b, w_ffn_gate, w_ffn_up, w_ffn_conv, b_ffn_conv, w_ffn_down, ln2_g, ln2_b) = lw
    m, s_gla_new, s_conv_new = _token_mixing(x, mem_k, mem_v, s_gla, s_conv, w_in, w_gla_a2, b_gla_a2,
                                             g_gla_norm, w_gla_out, w_conv, w_conv_out, w_mem_out, w_o)
    x = _layer_norm(DN_ALPHA * x + m, ln1_g, ln1_b)
    f, s_ffn_new = _conv_ffn(x, s_ffn, w_ffn_gate, w_ffn_up, w_ffn_conv, b_ffn_conv, w_ffn_down)
    x = _layer_norm(DN_ALPHA * x + f, ln2_g, ln2_b)
    return x, s_gla_new, s_conv_new, s_ffn_new


def setup_inputs(seed: int = 0) -> dict:
    key = jax.random.key(seed)
    ks = jax.random.split(key, 32)
    f32 = jnp.float32

    def nrm(k, shape, scale):
        return jax.random.normal(k, shape, f32) * scale

    D = D_MODEL
    return {
        'x_prompt': nrm(ks[0], (BATCH, SEQ, D), 1.0),
        'x_sample': nrm(ks[1], (DEC_BATCH, DEC_SEQ, D), 1.0),
        'mem_prompt': nrm(ks[2], (BATCH, N_MEM, D), 1.0),
        'cache_mem_k': nrm(ks[3], (DEPTH, DEC_BATCH, N_MEM, MEM_HEADS, MEM_HD), 1.0),
        'cache_mem_v': nrm(ks[4], (DEPTH, DEC_BATCH, N_MEM, MEM_HEADS, MEM_HD), 1.0),
        'state_gla': nrm(ks[5], (DEPTH, DEC_BATCH, GLA_HEADS, GLA_HK, GLA_HV), 0.5),
        'state_conv': nrm(ks[6], (DEPTH, DEC_BATCH, CONV_K - 1, CONV_DIM), 1.0),
        'state_ffn_conv': nrm(ks[7], (DEPTH, DEC_BATCH, FFN_CONV_K - 1, D_FF), 1.0),
        'w_in': nrm(ks[8], (DEPTH, D, IN_COLS), D ** -0.5),
        'w_gla_a2': nrm(ks[9], (DEPTH, GLA_RANK, GLA_DK), GLA_RANK ** -0.5),
        'b_gla_a2': nrm(ks[10], (DEPTH, GLA_DK), 0.1),
        'g_gla_norm': 1.0 + nrm(ks[11], (DEPTH, GLA_HV), 0.02),
        'w_gla_out': nrm(ks[12], (DEPTH, GLA_DV, D), GLA_DV ** -0.5),
        'w_conv': nrm(ks[13], (DEPTH, CONV_K, CONV_DIM), CONV_K ** -0.5),
        'w_conv_out': nrm(ks[14], (DEPTH, CONV_DIM, D), CONV_DIM ** -0.5),
        'w_mem_k': nrm(ks[15], (DEPTH, D, MEM_DIM), D ** -0.5),
        'w_mem_v': nrm(ks[16], (DEPTH, D, MEM_DIM), D ** -0.5),
        'w_mem_out': nrm(ks[17], (DEPTH, MEM_DIM, D), MEM_DIM ** -0.5),
        'w_o': nrm(ks[18], (DEPTH, D, D), DN_BETA * D ** -0.5),
        'ln1_g': 1.0 + nrm(ks[19], (DEPTH, D), 0.02),
        'ln1_b': nrm(ks[20], (DEPTH, D), 0.02),
        'w_ffn_gate': nrm(ks[21], (DEPTH, D, D_FF), D ** -0.5),
        'w_ffn_up': nrm(ks[22], (DEPTH, D, D_FF), D ** -0.5),
        'w_ffn_conv': nrm(ks[23], (DEPTH, FFN_CONV_K, D_FF), FFN_CONV_K ** -0.5),
        'b_ffn_conv': nrm(ks[24], (DEPTH, D_FF), 0.02),
        'w_ffn_down': nrm(ks[25], (DEPTH, D_FF, D), DN_BETA * D_FF ** -0.5),
        'ln2_g': 1.0 + nrm(ks[26], (DEPTH, D), 0.02),
        'ln2_b': nrm(ks[27], (DEPTH, D), 0.02),
    }


def reference(x_prompt, x_sample, mem_prompt, cache_mem_k, cache_mem_v, state_gla, state_conv, state_ffn_conv,
              w_in, w_gla_a2, b_gla_a2, g_gla_norm, w_gla_out, w_conv, w_conv_out, w_mem_k, w_mem_v, w_mem_out,
              w_o, ln1_g, ln1_b, w_ffn_gate, w_ffn_up, w_ffn_conv, b_ffn_conv, w_ffn_down, ln2_g, ln2_b):
    yp = x_prompt
    ys = x_sample
    bp = x_prompt.shape[0]
    dt = x_prompt.dtype
    p_mk, p_mv, p_gla, p_conv, p_ffn = [], [], [], [], []
    s_gla, s_conv, s_ffn = [], [], []
    for l in range(DEPTH):
        lw = (w_in[l], w_gla_a2[l], b_gla_a2[l], g_gla_norm[l], w_gla_out[l], w_conv[l], w_conv_out[l],
              w_mem_out[l], w_o[l], ln1_g[l], ln1_b[l], w_ffn_gate[l], w_ffn_up[l], w_ffn_conv[l],
              b_ffn_conv[l], w_ffn_down[l], ln2_g[l], ln2_b[l])
        mk = jnp.einsum('bmd,de->bme', mem_prompt, w_mem_k[l]).reshape(bp, N_MEM, MEM_HEADS, MEM_HD)
        mv = jnp.einsum('bmd,de->bme', mem_prompt, w_mem_v[l]).reshape(bp, N_MEM, MEM_HEADS, MEM_HD)
        yp, g_new, c_new, f_new = _layer(
            yp, mk, mv,
            jnp.zeros((bp, GLA_HEADS, GLA_HK, GLA_HV), dt),
            jnp.zeros((bp, CONV_K - 1, CONV_DIM), dt),
            jnp.zeros((bp, FFN_CONV_K - 1, D_FF), dt), lw)
        p_mk.append(mk)
        p_mv.append(mv)
        p_gla.append(g_new)
        p_conv.append(c_new)
        p_ffn.append(f_new)
        ys, g2, c2, f2 = _layer(ys, cache_mem_k[l], cache_mem_v[l], state_gla[l], state_conv[l],
                                state_ffn_conv[l], lw)
        s_gla.append(g2)
        s_conv.append(c2)
        s_ffn.append(f2)
    return (yp, ys, jnp.stack(p_mk), jnp.stack(p_mv), jnp.stack(p_gla), jnp.stack(p_conv), jnp.stack(p_ffn),
            jnp.stack(s_gla), jnp.stack(s_conv), jnp.stack(s_ffn))
```

```cpp
#include <hip/hip_runtime.h>
#include <hip/hip_cooperative_groups.h>
#include <cstdio>
#include <cstring>
namespace cg = cooperative_groups;

namespace pg8 {
#define PG8_LAS __attribute__((address_space(3)))
typedef unsigned short bf16_t;
typedef short bf16x8 __attribute__((ext_vector_type(8)));
typedef float f32x4 __attribute__((ext_vector_type(4)));
typedef unsigned u32x4 __attribute__((ext_vector_type(4)));
typedef unsigned u32x2 __attribute__((ext_vector_type(2)));
constexpr int BM = 256, BK = 64, HALF = 128, HTB = HALF * BK * 2, STAGE_BYTES = 8 * HTB, NXCD = 8, WGM = 8;
__host__ __device__ __forceinline__ int lds_byte(int r, int c) { const int st = (r >> 4) * 2 + (c >> 5), rr = r & 15, cc = c & 31, ob = rr * 64 + cc * 2; return st * 1024 + (ob ^ (((ob >> 9) & 1) << 5)); }
__host__ __device__ __forceinline__ void stage_rc(int b, int& R, int& C) { const int st = b / 1024, sb = b % 1024, swz = sb ^ (((sb >> 9) & 1) << 5); R = (st >> 1) * 16 + swz / 64; C = (st & 1) * 32 + (swz % 64) / 2; }
__host__ __device__ __forceinline__ int perm32(int rho) { const int n = rho >> 4, i = rho & 15; return 8 * (i >> 2) + 4 * n + (i & 3); }
struct Unit { int pm, pn; };
struct Gemm { const bf16_t* A; const bf16_t* Bt; int M, N, K; };
struct StaticOrder {
    int nM, nN, nwg, G, c;
    __host__ __device__ void init(int M, int N, int G_, int c_) { nM = M / BM; nN = N / BM; nwg = nM * nN; G = G_; c = c_; }
    __host__ __device__ bool next(int i, Unit& u) const {
        const long L = (long)i * G + c; if (L >= nwg) return false;
        int wgid = (int)L; { const int q = nwg / NXCD, r = nwg % NXCD, xcd = wgid % NXCD, off = wgid / NXCD; wgid = (xcd < r ? xcd * (q + 1) : r * (q + 1) + (xcd - r) * q) + off; }
        const int nig = WGM * nN, gid = wgid / nig, fm = gid * WGM, gsz = (nM - fm) < WGM ? (nM - fm) : WGM;
        u.pm = fm + ((wgid % nig) % gsz); u.pn = (wgid % nig) / gsz; return true;
    }
    __device__ __forceinline__ void a_ready(const Unit&) const {}
    __device__ __forceinline__ void done(const Unit&) const {}
};
__device__ __forceinline__ unsigned cvt_pk_bf16(float lo, float hi) { unsigned r; asm volatile("v_cvt_pk_bf16_f32 %0, %1, %2" : "=v"(r) : "v"(lo), "v"(hi)); return r; }

template <class Epi, class Sched, bool STAMP = false>
__device__ __forceinline__ void gemm_phase(PG8_LAS unsigned char* lds, const Gemm g, const Sched& S, const Epi& E, unsigned long long* stamps) {
    const int tid = threadIdx.x, wid = __builtin_amdgcn_readfirstlane(tid >> 6), lane = tid & 63, wr = wid >> 2, wc = wid & 3, fr = lane & 15, fq = lane >> 4;
    const int K = g.K, nt = K / BK;
    int ts_lo = 0, ts_hi = 0, nts = 0; const unsigned long long rt_entry = STAMP ? (unsigned long long)wall_clock64() : 0ull;
#define PG8_STAMP() do { if (STAMP && wid == 0 && nts < 64) { const unsigned long long _c = (unsigned long long)clock64(); \
        ts_lo = (lane == nts) ? (int)(unsigned)_c : ts_lo; ts_hi = (lane == nts) ? (int)(unsigned)(_c >> 32) : ts_hi; ++nts; } } while (0)
    PG8_STAMP();
    unsigned voffA[2], voffB[2];
#pragma unroll
    for (int i = 0; i < 2; ++i) { int R, C; stage_rc(tid * 16 + i * 8192, R, C); const int Rb = Epi::PERM ? ((R & ~31) + perm32(R & 31)) : R;
        voffA[i] = (unsigned)(R * K + C) * 2u; voffB[i] = (unsigned)(Rb * K + C) * 2u; }
    const size_t kstep = (size_t)(BK * 2);
    const size_t hstep = (size_t)HALF * K * 2;
    const size_t tstep = 2 * hstep;
    const unsigned ldsw = (unsigned)wid * 1024u;
    const int aoff = lds_byte(wr * 64 + fr, fq * 8), boff = lds_byte(wc * 32 + fr, fq * 8);
#define PG8_SA(b, h) (((b) * 2 + (h)) * HTB)
#define PG8_SB(b, h) ((4 + (b) * 2 + (h)) * HTB)
#define PG8_STAGE(bufoff, gbase, voff) do { _Pragma("unroll") for (int _i = 0; _i < 2; ++_i) \
        __builtin_amdgcn_global_load_lds((const unsigned*)((const char*)(gbase) + (voff)[_i]), (PG8_LAS unsigned*)(lds + (bufoff) + ldsw + _i * 8192), 16, 0, 0); } while (0)
#define PG8_LDA(dst, b, h) do { _Pragma("unroll") for (int m = 0; m < 4; ++m) _Pragma("unroll") for (int k = 0; k < 2; ++k) dst[m][k] = *(const PG8_LAS bf16x8*)(lds + PG8_SA(b, h) + aoff + m * 2048 + k * 1024); } while (0)
#define PG8_LDB(dst, b, h) do { _Pragma("unroll") for (int n = 0; n < 2; ++n) _Pragma("unroll") for (int k = 0; k < 2; ++k) dst[n][k] = *(const PG8_LAS bf16x8*)(lds + PG8_SB(b, h) + boff + n * 2048 + k * 1024); } while (0)
#define PG8_MMA(ai, bj, At, Bt) do { __builtin_amdgcn_s_setprio(1); _Pragma("unroll") for (int m = 0; m < 4; ++m) _Pragma("unroll") for (int n = 0; n < 2; ++n) _Pragma("unroll") for (int k = 0; k < 2; ++k) \
        acc[ai][bj][m][n] = __builtin_amdgcn_mfma_f32_16x16x32_bf16(Bt[n][k], At[m][k], acc[ai][bj][m][n], 0, 0, 0); __builtin_amdgcn_s_setprio(0); } while (0)
#define PG8_WAIT_V(n) asm volatile("s_waitcnt vmcnt(" #n ")" ::: "memory")
#define PG8_WAIT_L(n) asm volatile("s_waitcnt lgkmcnt(" #n ")" ::: "memory")
#define PG8_BAR __builtin_amdgcn_s_barrier()
#define PG8_SCHED __builtin_amdgcn_sched_barrier(0)
    Unit cur, nxt; int ui = 0;
    if (!S.next(0, cur)) return;
    f32x4 acc[2][2][4][2];
#pragma unroll
    for (int a = 0; a < 2; ++a)
#pragma unroll
        for (int b = 0; b < 2; ++b)
#pragma unroll
            for (int m = 0; m < 4; ++m)
#pragma unroll
                for (int n = 0; n < 2; ++n) acc[a][b][m][n] = (f32x4){0.f, 0.f, 0.f, 0.f};
    bf16x8 At[4][2], B0[2][2], B1[2][2];
    const char* cA = (const char*)g.A + (size_t)cur.pm * tstep; const char* cB = (const char*)g.Bt + (size_t)cur.pn * tstep;
    S.a_ready(cur);
    PG8_STAGE(PG8_SB(0, 0), cB, voffB); PG8_STAGE(PG8_SA(0, 0), cA, voffA); PG8_STAGE(PG8_SB(0, 1), cB + hstep, voffB); PG8_STAGE(PG8_SA(0, 1), cA + hstep, voffA);
    if (wr == 1) PG8_BAR;
    PG8_WAIT_V(4); PG8_BAR;
    PG8_STAGE(PG8_SB(1, 0), cB + kstep, voffB); PG8_STAGE(PG8_SA(1, 0), cA + kstep, voffA); PG8_STAGE(PG8_SB(1, 1), cB + hstep + kstep, voffB);
    PG8_WAIT_V(6); PG8_BAR;
    PG8_STAMP();
    for (;;) {
        const bool has_next = S.next(ui + 1, nxt);
        const char* nA = has_next ? (const char*)g.A + (size_t)nxt.pm * tstep : cA; const char* nB = has_next ? (const char*)g.Bt + (size_t)nxt.pn * tstep : cB;
        for (int t = 0; t < nt; t += 2) {
            const bool last = (t == nt - 2);
            const char* a1 = cA + (size_t)(t + 1) * kstep;
            const char* a2 = last ? nA : cA + (size_t)(t + 2) * kstep; const char* b2 = last ? nB : cB + (size_t)(t + 2) * kstep;
            const char* a3 = a2 + kstep; const char* b3 = b2 + kstep;
            if (last && has_next) S.a_ready(nxt);
            PG8_LDB(B0, 0, 0); PG8_SCHED; PG8_LDA(At, 0, 0); PG8_STAGE(PG8_SA(1, 1), a1 + hstep, voffA);
            PG8_WAIT_L(8); PG8_BAR; PG8_WAIT_L(0); PG8_MMA(0, 0, At, B0); PG8_BAR; PG8_SCHED;
            PG8_LDB(B1, 0, 1); PG8_STAGE(PG8_SB(0, 0), b2, voffB);
            PG8_BAR; PG8_WAIT_L(0); PG8_MMA(0, 1, At, B1); PG8_BAR;
            PG8_LDA(At, 0, 1); PG8_STAGE(PG8_SA(0, 0), a2, voffA);
            PG8_BAR; PG8_WAIT_L(0); PG8_MMA(1, 0, At, B0); PG8_BAR; PG8_SCHED;
            PG8_STAGE(PG8_SB(0, 1), b2 + hstep, voffB);
            PG8_WAIT_V(6); PG8_BAR; PG8_MMA(1, 1, At, B1); PG8_BAR;
            PG8_LDB(B0, 1, 0); PG8_SCHED; PG8_LDA(At, 1, 0); PG8_STAGE(PG8_SA(0, 1), a2 + hstep, voffA);
            PG8_WAIT_L(8); PG8_BAR; PG8_WAIT_L(0); PG8_MMA(0, 0, At, B0); PG8_BAR; PG8_SCHED;
            PG8_LDB(B1, 1, 1); PG8_STAGE(PG8_SB(1, 0), b3, voffB);
            PG8_BAR; PG8_WAIT_L(0); PG8_MMA(0, 1, At, B1); PG8_BAR;
            PG8_LDA(At, 1, 1); PG8_STAGE(PG8_SA(1, 0), a3, voffA);
            PG8_BAR; PG8_WAIT_L(0); PG8_MMA(1, 0, At, B0); PG8_BAR; PG8_SCHED;
            PG8_STAGE(PG8_SB(1, 1), b3 + hstep, voffB);
            PG8_WAIT_V(6); PG8_BAR; PG8_MMA(1, 1, At, B1); PG8_BAR;
        }
        PG8_STAMP();
        if constexpr (!Epi::AFTER_DRAIN) { E(acc, cur, wr, wc, fr, fq); S.done(cur); }
        PG8_STAMP();
        if (!has_next) break;
#pragma unroll
        for (int a = 0; a < 2; ++a)
#pragma unroll
            for (int b = 0; b < 2; ++b)
#pragma unroll
                for (int m = 0; m < 4; ++m)
#pragma unroll
                    for (int n = 0; n < 2; ++n) acc[a][b][m][n] = (f32x4){0.f, 0.f, 0.f, 0.f};
        cur = nxt; cA = nA; cB = nB; ++ui;
    }
    PG8_WAIT_V(0);
    if (wr == 0) PG8_BAR;
    PG8_BAR;
    if constexpr (Epi::AFTER_DRAIN) { E.fused(acc, cur, wr, wc, fr, fq, lds, wid, lane); S.done(cur); }
    PG8_STAMP();
    if (STAMP && wid == 0) { stamps[lane] = lane < nts ? (((unsigned long long)(unsigned)ts_hi << 32) | (unsigned)ts_lo) : 0ull;
        if (lane == 62) stamps[62] = rt_entry; if (lane == 63) stamps[63] = (unsigned long long)wall_clock64(); }
#undef PG8_STAMP
#undef PG8_SA
#undef PG8_SB
#undef PG8_STAGE
#undef PG8_LDA
#undef PG8_LDB
#undef PG8_MMA
#undef PG8_WAIT_V
#undef PG8_WAIT_L
#undef PG8_BAR
#undef PG8_SCHED
}
}

using pg8::bf16_t; using pg8::bf16x8; using pg8::f32x4; using pg8::u32x4; using pg8::u32x2;

constexpr int D = 2048, NP = 8192, NS = 128, NR = 8320, NRP = 8448;
constexpr int NIN = 16384, LDP = 16384, WIN_LD = 16400;
constexpr int DFF = 5504, NGU = 11008;
constexpr int Q_OFF = 0, K_OFF = 1024, V_OFF = 2048, G_OFF = 4096, CB_OFF = 6144, CC_OFF = 7168, CH_OFF = 8192, MQ_OFF = 9216, ZA_OFF = 10240, ZB_OFF = 12288, ZM_OFF = 14336;
constexpr float DN_ALPHA = 1.189207115002721f;
constexpr int LDS_BYTES = 158 * 1024;

constexpr size_t O_CTRL = 0;
constexpr size_t O_XB   = 4096;
constexpr size_t O_MEMB = O_XB + (size_t)NRP * D * 2;
constexpr size_t O_WIN  = O_MEMB + (size_t)1024 * D * 2;
constexpr size_t O_WALR = O_WIN + (size_t)NIN * D * 2;
constexpr size_t O_WGO  = O_WALR + (size_t)16 * D * 2;
constexpr size_t O_WCO  = O_WGO + (size_t)D * D * 2;
constexpr size_t O_WMO  = O_WCO + (size_t)D * 1024 * 2;
constexpr size_t O_WO   = O_WMO + (size_t)D * 1024 * 2;
constexpr size_t O_WMKV = O_WO + (size_t)D * D * 2;
constexpr size_t O_WGU  = O_WMKV + (size_t)D * D * 2;
constexpr size_t O_WD   = O_WGU + (size_t)NGU * D * 2;
constexpr size_t O_P    = O_WD + (size_t)D * DFF * 2;
constexpr size_t O_BC   = O_P + (size_t)NR * LDP * 2;
constexpr size_t O_MKB  = O_BC + (size_t)NR * 1024 * 4;
constexpr size_t O_MVT  = O_MKB + (size_t)1024 * 1024 * 2;
constexpr size_t O_OG   = O_MVT + (size_t)1024 * 1024 * 2;
constexpr size_t O_MGF  = O_OG + (size_t)NR * D * 4;
constexpr size_t O_AA   = O_MGF + (size_t)NP * D * 4;
constexpr size_t O_AB   = O_AA + (size_t)NR * D * 2;
constexpr size_t O_AM   = O_AB + (size_t)NR * 1024 * 2;
constexpr size_t O_MGB  = O_AM + (size_t)NR * 1024 * 2;
constexpr size_t O_H1   = O_MGB + (size_t)NR * D * 2;
constexpr size_t O_X1F  = O_H1 + (size_t)NR * D * 4;
constexpr size_t O_X1B  = O_X1F + (size_t)NR * D * 4;
constexpr size_t WS_TOTAL = O_X1B + (size_t)NRP * D * 2;
static_assert(WS_TOTAL <= (size_t)1073741824, "workspace too large");
static_assert((size_t)NRP * NGU * 2 <= (size_t)NR * LDP * 2, "HGU alias");
static_assert((size_t)NR * DFF * 2 <= (size_t)NR * D * 4 + (size_t)NP * D * 4, "A_ffn alias");

constexpr size_t OUT_YP = 0;
constexpr size_t OUT_YS = OUT_YP + (size_t)NP * D;
constexpr size_t OUT_PMK = OUT_YS + (size_t)NS * D;
constexpr size_t OUT_PMV = OUT_PMK + (size_t)1024 * 1024;
constexpr size_t OUT_PGLA = OUT_PMV + (size_t)1024 * 1024;
constexpr size_t OUT_PCONV = OUT_PGLA + (size_t)4 * 4 * 256 * 512;
constexpr size_t OUT_PFFN = OUT_PCONV + (size_t)4 * 2 * 1024;
constexpr size_t OUT_SGLA = OUT_PFFN + (size_t)4 * 2 * DFF;
constexpr size_t OUT_SCONV = OUT_SGLA + (size_t)NS * 4 * 256 * 512;
constexpr size_t OUT_SFFN = OUT_SCONV + (size_t)NS * 2 * 1024;

struct Params {
    const float* in[28];
    float* out;
    unsigned char* ws;
};
constexpr int TB1 = 1536, TB2 = 4096, TB3 = 4608, TB4 = 4864, TB5 = 5120, TB6 = 5376, TB7 = 5632, TB8 = 6144, TB9 = 7520, TB10 = 8896, NTILES = 10272;

__device__ __forceinline__ unsigned pk2(float lo, float hi) { unsigned r; asm("v_cvt_pk_bf16_f32 %0, %1, %2" : "=v"(r) : "v"(lo), "v"(hi)); return r; }
__device__ __forceinline__ float bflo(unsigned w) { return __uint_as_float(w << 16); }
__device__ __forceinline__ float bfhi(unsigned w) { return __uint_as_float(w & 0xffff0000u); }
__device__ __forceinline__ float bf2f(bf16_t b) { return __uint_as_float(((unsigned)b) << 16); }
__device__ __forceinline__ float sigm(float x) { return 1.0f / (1.0f + __expf(-x)); }
__device__ __forceinline__ float silu(float x) { return x / (1.0f + __expf(-x)); }
__device__ __forceinline__ float wave_sum(float v) { for (int o = 32; o >= 1; o >>= 1) v += __shfl_xor(v, o); return v; }
__device__ __forceinline__ f32x4 mfma16(bf16x8 x, bf16x8 y, f32x4 c) { return __builtin_amdgcn_mfma_f32_16x16x32_bf16(x, y, c, 0, 0, 0); }
__device__ __forceinline__ bf16x8 ld8(const bf16_t* p) { return *(const bf16x8*)p; }
__device__ __forceinline__ void unpack8(u32x4 w, float (&f)[8]) { f[0] = bflo(w.x); f[1] = bfhi(w.x); f[2] = bflo(w.y); f[3] = bfhi(w.y); f[4] = bflo(w.z); f[5] = bfhi(w.z); f[6] = bflo(w.w); f[7] = bfhi(w.w); }
__device__ __forceinline__ u32x4 pack8(const float (&f)[8]) { u32x4 w; w.x = pk2(f[0], f[1]); w.y = pk2(f[2], f[3]); w.z = pk2(f[4], f[5]); w.w = pk2(f[6], f[7]); return w; }

__device__ __forceinline__ int inproj_mode(int col) { return col < 1024 ? 1 : col < 4096 ? 0 : col < 6144 ? 2 : col < 9216 ? 0 : col < 10240 ? 1 : 3; }
__device__ __forceinline__ f32x4 inproj_act(f32x4 v, int mode) {
    if (mode == 1) { v = v * 0.0625f; }
    else if (mode == 2) { v[0] = silu(v[0]); v[1] = silu(v[1]); v[2] = silu(v[2]); v[3] = silu(v[3]); }
    else if (mode == 3) { v[0] = sigm(v[0]); v[1] = sigm(v[1]); v[2] = sigm(v[2]); v[3] = sigm(v[3]); }
    return v;
}

struct EpiInproj {
    static constexpr bool PERM = true, AFTER_DRAIN = false;
    bf16_t* O;
    __device__ __forceinline__ void operator()(const f32x4 (&acc)[2][2][4][2], const pg8::Unit& u, int wr, int wc, int fr, int fq) const {
        const int mode = inproj_mode(u.pn * 256);
        const int row0 = u.pm * 256 + wr * 64 + fr, col0 = u.pn * 256 + wc * 32 + 8 * fq;
#pragma unroll
        for (int ai = 0; ai < 2; ++ai)
#pragma unroll
            for (int m = 0; m < 4; ++m) { bf16_t* rowp = O + (size_t)(row0 + ai * 128 + m * 16) * LDP + col0;
#pragma unroll
                for (int bj = 0; bj < 2; ++bj) { const f32x4 v0 = inproj_act(acc[ai][bj][m][0], mode), v1 = inproj_act(acc[ai][bj][m][1], mode);
                    u32x4 w; w.x = pk2(v0[0], v0[1]); w.y = pk2(v0[2], v0[3]); w.z = pk2(v1[0], v1[1]); w.w = pk2(v1[2], v1[3]);
                    *(u32x4*)(rowp + bj * 128) = w; } }
    }
};
struct EpiBf16 {
    static constexpr bool PERM = true, AFTER_DRAIN = false;
    bf16_t* O; int ldc;
    __device__ __forceinline__ void operator()(const f32x4 (&acc)[2][2][4][2], const pg8::Unit& u, int wr, int wc, int fr, int fq) const {
        const int row0 = u.pm * 256 + wr * 64 + fr, col0 = u.pn * 256 + wc * 32 + 8 * fq;
#pragma unroll
        for (int ai = 0; ai < 2; ++ai)
#pragma unroll
            for (int m = 0; m < 4; ++m) { bf16_t* rowp = O + (size_t)(row0 + ai * 128 + m * 16) * ldc + col0;
#pragma unroll
                for (int bj = 0; bj < 2; ++bj) { const f32x4 v0 = acc[ai][bj][m][0], v1 = acc[ai][bj][m][1];
                    u32x4 w; w.x = pk2(v0[0], v0[1]); w.y = pk2(v0[2], v0[3]); w.z = pk2(v1[0], v1[1]); w.w = pk2(v1[2], v1[3]);
                    *(u32x4*)(rowp + bj * 128) = w; } }
    }
};
struct EpiMerge {
    static constexpr bool PERM = false, AFTER_DRAIN = false;
    const bf16_t* P; float* MGf; bf16_t* MGb; int zoff, mode;
    __device__ __forceinline__ void operator()(const f32x4 (&acc)[2][2][4][2], const pg8::Unit& u, int wr, int wc, int fr, int fq) const {
        const int row0 = u.pm * 256 + wr * 64 + fr, col0 = u.pn * 256 + wc * 32 + 4 * fq;
#pragma unroll
        for (int ai = 0; ai < 2; ++ai)
#pragma unroll
            for (int m = 0; m < 4; ++m) { const size_t row = (size_t)(row0 + ai * 128 + m * 16);
#pragma unroll
                for (int bj = 0; bj < 2; ++bj)
#pragma unroll
                    for (int n = 0; n < 2; ++n) { const int col = col0 + bj * 128 + n * 16;
                        const u32x2 gw = *(const u32x2*)(P + row * LDP + zoff + col);
                        f32x4 g; g[0] = bflo(gw.x); g[1] = bfhi(gw.x); g[2] = bflo(gw.y); g[3] = bfhi(gw.y);
                        f32x4 v = g * acc[ai][bj][m][n];
                        float* mp = MGf + row * D + col;
                        if (mode == 0) { *(f32x4*)mp = v; }
                        else if (mode == 1) { *(f32x4*)mp = *(const f32x4*)mp + v; }
                        else { v = v + *(const f32x4*)mp; u32x2 w; w.x = pk2(v[0], v[1]); w.y = pk2(v[2], v[3]); *(u32x2*)(MGb + row * D + col) = w; } } }
    }
};
struct EpiResid {
    static constexpr bool PERM = false, AFTER_DRAIN = false;
    const float* resid; float* out;
    __device__ __forceinline__ void operator()(const f32x4 (&acc)[2][2][4][2], const pg8::Unit& u, int wr, int wc, int fr, int fq) const {
        const int row0 = u.pm * 256 + wr * 64 + fr, col0 = u.pn * 256 + wc * 32 + 4 * fq;
#pragma unroll
        for (int ai = 0; ai < 2; ++ai)
#pragma unroll
            for (int m = 0; m < 4; ++m) { const size_t ro = (size_t)(row0 + ai * 128 + m * 16) * D + col0;
#pragma unroll
                for (int bj = 0; bj < 2; ++bj)
#pragma unroll
                    for (int n = 0; n < 2; ++n) { const size_t o = ro + bj * 128 + n * 16;
                        *(f32x4*)(out + o) = *(const f32x4*)(resid + o) * DN_ALPHA + acc[ai][bj][m][n]; } }
    }
};

template <int NT, bool SWAP>
__device__ __forceinline__ void skinny_mma(f32x4 (&acc)[NT], const bf16_t* ap, const bf16_t* bp, size_t bstep, int K) {
#pragma unroll 4
    for (int k = 0; k < K; k += 32) {
        const bf16x8 a = ld8(ap + k);
#pragma unroll
        for (int n = 0; n < NT; ++n) { const bf16x8 b = ld8(bp + (size_t)n * bstep + k); acc[n] = SWAP ? mfma16(a, b, acc[n]) : mfma16(b, a, acc[n]); }
    }
}

__device__ __forceinline__ void phase_convert(const Params& p, unsigned char* smem) {
    float* T = (float*)smem;
    const int tid = threadIdx.x, G = gridDim.x;
    unsigned char* ws = p.ws;
    for (int tile = blockIdx.x; tile < NTILES; tile += G) {
        const float* src = p.in[8]; bf16_t* dst = (bf16_t*)(ws + O_WIN); int src_ld = WIN_LD, c0 = 0, K = D, ntn = 48, tb = 0;
#define TDSEL(TB, SRC, DST, LD, C0, KK, NN) if (tile >= (TB)) { src = (SRC); dst = (bf16_t*)(DST); src_ld = (LD); c0 = (C0); K = (KK); ntn = (NN) / 128; tb = (TB); }
        TDSEL(TB1, p.in[8], ws + O_WIN + (size_t)6144 * D * 2, WIN_LD, 6160, D, 10240)
        TDSEL(TB2, p.in[12], ws + O_WGO, D, 0, D, D)
        TDSEL(TB3, p.in[14], ws + O_WCO, D, 0, 1024, D)
        TDSEL(TB4, p.in[15], ws + O_WMKV, 1024, 0, D, 1024)
        TDSEL(TB5, p.in[16], ws + O_WMKV + (size_t)1024 * D * 2, 1024, 0, D, 1024)
        TDSEL(TB6, p.in[17], ws + O_WMO, D, 0, 1024, D)
        TDSEL(TB7, p.in[18], ws + O_WO, D, 0, D, D)
        TDSEL(TB8, p.in[21], ws + O_WGU, DFF, 0, D, DFF)
        TDSEL(TB9, p.in[22], ws + O_WGU + (size_t)DFF * D * 2, DFF, 0, D, DFF)
        TDSEL(TB10, p.in[25], ws + O_WD, D, 0, DFF, D)
#undef TDSEL
        const int lt = tile - tb, kt = lt / ntn, nt = lt - kt * ntn, k0 = kt * 64, n0 = nt * 128;
#pragma unroll
        for (int i = 0; i < 4; ++i) { const int f = tid + 512 * i, kk = f >> 5, n4 = f & 31;
            const f32x4 v = *(const f32x4*)(src + (size_t)(k0 + kk) * src_ld + c0 + n0 + 4 * n4);
            *(f32x4*)(T + kk * 132 + 4 * n4) = v; }
        __syncthreads();
#pragma unroll
        for (int i = 0; i < 2; ++i) { const int it = tid + 512 * i, kg = it & 7, n = it >> 3;
            float f[8];
#pragma unroll
            for (int e = 0; e < 8; ++e) f[e] = T[(8 * kg + e) * 132 + n];
            *(u32x4*)(dst + (size_t)(n0 + n) * K + k0 + 8 * kg) = pack8(f); }
        __syncthreads();
    }
    bf16_t* Xb = (bf16_t*)(ws + O_XB); bf16_t* Memb = (bf16_t*)(ws + O_MEMB); bf16_t* X1b = (bf16_t*)(ws + O_X1B); bf16_t* Walr = (bf16_t*)(ws + O_WALR);
    const size_t stride = (size_t)G * 512, t0 = (size_t)blockIdx.x * 512 + tid;
    for (size_t it = t0; it < (size_t)NRP * 256; it += stride) { const int row = (int)(it >> 8), c8 = (int)(it & 255) * 8;
        u32x4 w = {0u, 0u, 0u, 0u};
        if (row < NR) { const float* s = row < NP ? p.in[0] + (size_t)row * D + c8 : p.in[1] + (size_t)(row - NP) * D + c8;
            const f32x4 a = *(const f32x4*)s, b = *(const f32x4*)(s + 4);
            w.x = pk2(a[0], a[1]); w.y = pk2(a[2], a[3]); w.z = pk2(b[0], b[1]); w.w = pk2(b[2], b[3]); }
        else { *(u32x4*)(X1b + (size_t)row * D + c8) = w; }
        *(u32x4*)(Xb + (size_t)row * D + c8) = w; }
    for (size_t it = t0; it < (size_t)1024 * 256; it += stride) { const float* s = p.in[2] + it * 8;
        const f32x4 a = *(const f32x4*)s, b = *(const f32x4*)(s + 4); u32x4 w;
        w.x = pk2(a[0], a[1]); w.y = pk2(a[2], a[3]); w.z = pk2(b[0], b[1]); w.w = pk2(b[2], b[3]);
        *(u32x4*)(Memb + it * 8) = w; }
    for (size_t it = t0; it < (size_t)16 * D; it += stride) { const int r = (int)(it >> 11), k = (int)(it & 2047);
        const float v = p.in[8][(size_t)k * WIN_LD + 6144 + r]; Walr[it] = (bf16_t)(pk2(v, 0.f) & 0xffffu); }
}

__device__ __forceinline__ void p1_sample_inproj(const Params& p, int j) {
    const int tid = threadIdx.x, w = tid >> 6, lane = tid & 63, fr = lane & 15, fq = lane >> 4;
    const bf16_t* Xb = (const bf16_t*)(p.ws + O_XB); const bf16_t* Win = (const bf16_t*)(p.ws + O_WIN); bf16_t* P = (bf16_t*)(p.ws + O_P);
    const int col0 = 64 * j, row = NP + 16 * w + fr;
    f32x4 acc[4];
#pragma unroll
    for (int n = 0; n < 4; ++n) acc[n] = (f32x4){0.f, 0.f, 0.f, 0.f};
    skinny_mma<4, false>(acc, Xb + (size_t)row * D + 8 * fq, Win + (size_t)(col0 + fr) * D + 8 * fq, (size_t)16 * D, D);
    const int mode = inproj_mode(col0);
#pragma unroll
    for (int n = 0; n < 4; ++n) { const f32x4 v = inproj_act(acc[n], mode); u32x2 o; o.x = pk2(v[0], v[1]); o.y = pk2(v[2], v[3]);
        *(u32x2*)(P + (size_t)row * LDP + col0 + 16 * n + 4 * fq) = o; }
}
__device__ __forceinline__ void p1_memkv(const Params& p, int j) {
    const int tid = threadIdx.x, w = tid >> 6, lane = tid & 63, fr = lane & 15, fq = lane >> 4;
    const bf16_t* Memb = (const bf16_t*)(p.ws + O_MEMB); const bf16_t* Wm = (const bf16_t*)(p.ws + O_WMKV);
    bf16_t* MKb = (bf16_t*)(p.ws + O_MKB); bf16_t* MVT = (bf16_t*)(p.ws + O_MVT);
    const int rb = j >> 5, cb = j & 31, col0 = 64 * cb, arow0 = 128 * rb + 16 * w;
    f32x4 acc[4];
#pragma unroll
    for (int n = 0; n < 4; ++n) acc[n] = (f32x4){0.f, 0.f, 0.f, 0.f};
    const bf16_t* ap = Memb + (size_t)(arow0 + fr) * D + 8 * fq; const bf16_t* bp = Wm + (size_t)(col0 + fr) * D + 8 * fq;
    if (col0 < 1024) {
        skinny_mma<4, false>(acc, ap, bp, (size_t)16 * D, D);
        const int row = arow0 + fr;
#pragma unroll
        for (int n = 0; n < 4; ++n) { const int col = col0 + 16 * n + 4 * fq;
            *(f32x4*)(p.out + OUT_PMK + (size_t)row * 1024 + col) = acc[n];
            u32x2 o; o.x = pk2(acc[n][0], acc[n][1]); o.y = pk2(acc[n][2], acc[n][3]); *(u32x2*)(MKb + (size_t)row * 1024 + col) = o; }
    } else {
        skinny_mma<4, true>(acc, ap, bp, (size_t)16 * D, D);
        const int row = arow0 + 4 * fq, b = row >> 8, mloc = row & 255;
#pragma unroll
        for (int n = 0; n < 4; ++n) { const int c = col0 - 1024 + 16 * n + fr;
#pragma unroll
            for (int r = 0; r < 4; ++r) p.out[OUT_PMV + (size_t)(row + r) * 1024 + c] = acc[n][r];
            u32x2 o; o.x = pk2(acc[n][0], acc[n][1]); o.y = pk2(acc[n][2], acc[n][3]); *(u32x2*)(MVT + ((size_t)b * 1024 + c) * 256 + mloc) = o; }
    }
}
__device__ __forceinline__ void p1_alr(const Params& p, unsigned char* smem, int j) {
    const int tid = threadIdx.x, w = tid >> 6, lane = tid & 63, fr = lane & 15, fq = lane >> 4;
    const bf16_t* Xb = (const bf16_t*)(p.ws + O_XB); const bf16_t* Walr = (const bf16_t*)(p.ws + O_WALR); float* BC = (float*)(p.ws + O_BC);
    float* part = (float*)smem; float* alr = part + 2048;
    const int rt = w & 3, kh = w >> 2;
    f32x4 acc[1]; acc[0] = (f32x4){0.f, 0.f, 0.f, 0.f};
    skinny_mma<1, false>(acc, Xb + (size_t)(64 * j + 16 * rt + fr) * D + kh * 1024 + 8 * fq, Walr + (size_t)fr * D + kh * 1024 + 8 * fq, 0, 1024);
    *(f32x4*)(part + (kh * 64 + 16 * rt + fr) * 16 + 4 * fq) = acc[0];
    __syncthreads();
    for (int i = tid; i < 1024; i += 512) alr[i] = part[i] + part[1024 + i];
    __syncthreads();
    const bool prompt = (64 * j) < NP;
    for (int cc = 0; cc < 2; ++cc) { const int k = tid + 512 * cc;
        float w2[16];
#pragma unroll
        for (int r = 0; r < 16; ++r) w2[r] = p.in[9][r * 1024 + k];
        const float bb = p.in[10][k]; float run = 0.f;
        for (int t = 0; t < 64; ++t) { float z = bb;
#pragma unroll
            for (int r4 = 0; r4 < 4; ++r4) { const f32x4 a = *(const f32x4*)(alr + t * 16 + 4 * r4); z += a[0] * w2[4 * r4] + a[1] * w2[4 * r4 + 1] + a[2] * w2[4 * r4 + 2] + a[3] * w2[4 * r4 + 3]; }
            const float la = (fminf(z, 0.f) - log1pf(__expf(-fabsf(z)))) * 0.0625f;
            run = prompt ? run + la : la;
            BC[(size_t)(64 * j + t) * 1024 + k] = run; } }
    __syncthreads();
}

constexpr int QS = 264, TS = 72;
__device__ __forceinline__ void gla_prompt_job(const Params& p, unsigned char* smem, int g) {
    const int tid = threadIdx.x, w = tid >> 6, lane = tid & 63, fr = lane & 15, fq = lane >> 4;
    const int b = g >> 5, h = (g >> 3) & 3, j = g & 7;
    const bf16_t* P = (const bf16_t*)(p.ws + O_P); const float* BC = (const float*)(p.ws + O_BC); float* OG = (float*)(p.ws + O_OG);
    bf16_t* Qt = (bf16_t*)smem; bf16_t* Kt = Qt + 64 * QS; bf16_t* ST = Kt + 64 * QS; bf16_t* KtT = ST + 64 * QS; bf16_t* VT = KtT + 256 * TS; bf16_t* Pm = VT + 64 * TS;
    float* Dk = (float*)(Pm + 64 * TS);
    for (int i = tid; i < 64 * QS / 8; i += 512) ((u32x4*)ST)[i] = (u32x4){0u, 0u, 0u, 0u};
    f32x4 sacc[2][4];
#pragma unroll
    for (int a = 0; a < 2; ++a)
#pragma unroll
        for (int c = 0; c < 4; ++c) sacc[a][c] = (f32x4){0.f, 0.f, 0.f, 0.f};
    const size_t R0 = (size_t)b * 2048;
    for (int n = 0; n < 32; ++n) {
        const size_t r0 = R0 + 64 * n;
#pragma unroll
        for (int i = 0; i < 4; ++i) { const int s = tid + 512 * i, t = s >> 5, ks = s & 31;
            const bf16_t* prow = P + (r0 + t) * LDP + h * 256 + 8 * ks;
            const u32x4 q8 = *(const u32x4*)(prow + Q_OFF), k8 = *(const u32x4*)(prow + K_OFF);
            const float* bcp = BC + (r0 + t) * 1024 + h * 256 + 8 * ks;
            const f32x4 b0 = *(const f32x4*)bcp, b1 = *(const f32x4*)(bcp + 4);
            float qf[8], kf[8]; unpack8(q8, qf); unpack8(k8, kf);
#pragma unroll
            for (int e = 0; e < 8; ++e) { const float bc = e < 4 ? b0[e & 3] : b1[e & 3]; qf[e] *= __expf(bc); kf[e] *= __expf(-bc); }
            *(u32x4*)(Qt + t * QS + 8 * ks) = pack8(qf); *(u32x4*)(Kt + t * QS + 8 * ks) = pack8(kf); }
        { const int t = tid >> 3, vs = tid & 7;
            const u32x4 v8 = *(const u32x4*)(P + (r0 + t) * LDP + V_OFF + h * 512 + j * 64 + 8 * vs);
            bf16_t* vp = VT + (8 * vs) * TS + t;
            vp[0 * TS] = (bf16_t)(v8.x & 0xffffu); vp[1 * TS] = (bf16_t)(v8.x >> 16); vp[2 * TS] = (bf16_t)(v8.y & 0xffffu); vp[3 * TS] = (bf16_t)(v8.y >> 16);
            vp[4 * TS] = (bf16_t)(v8.z & 0xffffu); vp[5 * TS] = (bf16_t)(v8.z >> 16); vp[6 * TS] = (bf16_t)(v8.w & 0xffffu); vp[7 * TS] = (bf16_t)(v8.w >> 16); }
        if (tid < 256) Dk[tid] = __expf(BC[(r0 + 63) * 1024 + h * 256 + tid]);
        __syncthreads();
#pragma unroll
        for (int i = 0; i < 4; ++i) { const int s = tid + 512 * i, t = s & 63, ks = s >> 6;
            const u32x4 k8 = *(const u32x4*)(Kt + t * QS + 8 * ks);
            bf16_t* kp = KtT + (8 * ks) * TS + t;
            kp[0 * TS] = (bf16_t)(k8.x & 0xffffu); kp[1 * TS] = (bf16_t)(k8.x >> 16); kp[2 * TS] = (bf16_t)(k8.y & 0xffffu); kp[3 * TS] = (bf16_t)(k8.y >> 16);
            kp[4 * TS] = (bf16_t)(k8.z & 0xffffu); kp[5 * TS] = (bf16_t)(k8.z >> 16); kp[6 * TS] = (bf16_t)(k8.w & 0xffffu); kp[7 * TS] = (bf16_t)(k8.w >> 16); }
#pragma unroll
        for (int i = 0; i < 2; ++i) { const int T = 2 * w + i, tt = T >> 2, st = T & 3;
            f32x4 a = (f32x4){0.f, 0.f, 0.f, 0.f};
            if (st <= tt) {
#pragma unroll
                for (int ks = 0; ks < 8; ++ks) a = mfma16(ld8(Kt + (16 * st + fr) * QS + 32 * ks + 8 * fq), ld8(Qt + (16 * tt + fr) * QS + 32 * ks + 8 * fq), a); }
            const int tl = 16 * tt + fr, sl = 16 * st + 4 * fq;
#pragma unroll
            for (int r = 0; r < 4; ++r) if (sl + r > tl) a[r] = 0.f;
            u32x2 o; o.x = pk2(a[0], a[1]); o.y = pk2(a[2], a[3]); *(u32x2*)(Pm + tl * TS + sl) = o; }
        __syncthreads();
#pragma unroll
        for (int i = 0; i < 2; ++i) { const int T = 2 * w + i, tt = T >> 2, vt = T & 3;
            f32x4 a = (f32x4){0.f, 0.f, 0.f, 0.f};
#pragma unroll
            for (int ks = 0; ks < 2; ++ks) a = mfma16(ld8(VT + (16 * vt + fr) * TS + 32 * ks + 8 * fq), ld8(Pm + (16 * tt + fr) * TS + 32 * ks + 8 * fq), a);
#pragma unroll
            for (int ks = 0; ks < 8; ++ks) a = mfma16(ld8(ST + (16 * vt + fr) * QS + 32 * ks + 8 * fq), ld8(Qt + (16 * tt + fr) * QS + 32 * ks + 8 * fq), a);
            *(f32x4*)(OG + (r0 + 16 * tt + fr) * D + h * 512 + j * 64 + 16 * vt + 4 * fq) = a; }
        __syncthreads();
#pragma unroll
        for (int k2 = 0; k2 < 2; ++k2) { const int kt = 2 * w + k2;
            const bf16x8 X0 = ld8(KtT + (16 * kt + fr) * TS + 8 * fq), X1 = ld8(KtT + (16 * kt + fr) * TS + 32 + 8 * fq);
            const f32x4 dk = *(const f32x4*)(Dk + 16 * kt + 4 * fq);
#pragma unroll
            for (int vt = 0; vt < 4; ++vt) { f32x4 a = sacc[k2][vt];
                a = mfma16(X0, ld8(VT + (16 * vt + fr) * TS + 8 * fq), a); a = mfma16(X1, ld8(VT + (16 * vt + fr) * TS + 32 + 8 * fq), a);
                a = a * dk; sacc[k2][vt] = a;
                u32x2 o; o.x = pk2(a[0], a[1]); o.y = pk2(a[2], a[3]); *(u32x2*)(ST + (16 * vt + fr) * QS + 16 * kt + 4 * fq) = o; } }
        __syncthreads();
    }
    float* so = p.out + OUT_PGLA + ((size_t)(b * 4 + h) * 256) * 512 + j * 64;
#pragma unroll
    for (int k2 = 0; k2 < 2; ++k2)
#pragma unroll
        for (int vt = 0; vt < 4; ++vt)
#pragma unroll
            for (int r = 0; r < 4; ++r) so[(size_t)(16 * (2 * w + k2) + 4 * fq + r) * 512 + 16 * vt + fr] = sacc[k2][vt][r];
}

__device__ __forceinline__ void gla_sample_job(const Params& p, unsigned char* smem, int jb) {
    const int tid = threadIdx.x; const int b = jb >> 2, h = jb & 3;
    const bf16_t* P = (const bf16_t*)(p.ws + O_P); const float* BC = (const float*)(p.ws + O_BC); float* OG = (float*)(p.ws + O_OG);
    float* sq = (float*)smem; float* sk = sq + 256; float* sa = sk + 256; float* red = sa + 256;
    const size_t row = (size_t)NP + b;
    if (tid < 256) { const bf16_t* prow = P + row * LDP + h * 256 + tid; sq[tid] = bf2f(prow[Q_OFF]); sk[tid] = bf2f(prow[K_OFF]); sa[tid] = __expf(BC[row * 1024 + h * 256 + tid]); }
    const int v4 = tid & 127, kg = tid >> 7;
    const u32x2 vv = *(const u32x2*)(P + row * LDP + V_OFF + h * 512 + 4 * v4);
    f32x4 v; v[0] = bflo(vv.x); v[1] = bfhi(vv.x); v[2] = bflo(vv.y); v[3] = bfhi(vv.y);
    __syncthreads();
    const f32x4* Sin = (const f32x4*)(p.in[5] + ((size_t)(b * 4 + h) * 256) * 512) + v4;
    f32x4* Sout = (f32x4*)(p.out + OUT_SGLA + ((size_t)(b * 4 + h) * 256) * 512) + v4;
    f32x4 o = (f32x4){0.f, 0.f, 0.f, 0.f};
#pragma unroll 8
    for (int kk = 0; kk < 64; ++kk) { const int k = kg * 64 + kk;
        f32x4 s = __builtin_nontemporal_load(Sin + (size_t)k * 128);
        s = s * sa[k] + v * sk[k];
        __builtin_nontemporal_store(s, Sout + (size_t)k * 128);
        o = o + s * sq[k]; }
    *(f32x4*)(red + kg * 512 + 4 * v4) = o;
    __syncthreads();
    if (tid < 128) { const f32x4 r = *(const f32x4*)(red + 4 * tid) + *(const f32x4*)(red + 512 + 4 * tid) + *(const f32x4*)(red + 1024 + 4 * tid) + *(const f32x4*)(red + 1536 + 4 * tid);
        *(f32x4*)(OG + row * D + h * 512 + 4 * tid) = r; }
    __syncthreads();
}

__device__ __forceinline__ void attn_prompt_job(const Params& p, int j) {
    const int tid = threadIdx.x, w = tid >> 6, lane = tid & 63, fr = lane & 15, fq = lane >> 4;
    const int b = j >> 6, h = (j >> 4) & 3, qt = j & 15;
    const bf16_t* P = (const bf16_t*)(p.ws + O_P); const bf16_t* MKb = (const bf16_t*)(p.ws + O_MKB); const bf16_t* MVT = (const bf16_t*)(p.ws + O_MVT); bf16_t* Am = (bf16_t*)(p.ws + O_AM);
    const size_t row = (size_t)b * 2048 + qt * 128 + 16 * w + fr;
    const bf16_t* qp = P + row * LDP + MQ_OFF + h * 256 + 8 * fq;
    bf16x8 Yq[8];
#pragma unroll
    for (int ks = 0; ks < 8; ++ks) Yq[ks] = ld8(qp + 32 * ks);
    f32x4 lg[16];
    const bf16_t* kp = MKb + (size_t)(b * 256 + fr) * 1024 + h * 256 + 8 * fq;
#pragma unroll
    for (int mt = 0; mt < 16; ++mt) { f32x4 a = (f32x4){0.f, 0.f, 0.f, 0.f};
#pragma unroll
        for (int ks = 0; ks < 8; ++ks) a = mfma16(ld8(kp + (size_t)mt * 16 * 1024 + 32 * ks), Yq[ks], a);
        lg[mt] = a; }
    float mx = -3.0e38f;
#pragma unroll
    for (int mt = 0; mt < 16; ++mt) mx = fmaxf(fmaxf(fmaxf(lg[mt][0], lg[mt][1]), fmaxf(lg[mt][2], lg[mt][3])), mx);
    mx = fmaxf(mx, __shfl_xor(mx, 16)); mx = fmaxf(mx, __shfl_xor(mx, 32));
    float sum = 0.f;
    bf16x8 Yp[8];
#pragma unroll
    for (int i = 0; i < 8; ++i) { u32x4 wv; f32x4 e0, e1;
#pragma unroll
        for (int r = 0; r < 4; ++r) { e0[r] = __expf(lg[2 * i][r] - mx); e1[r] = __expf(lg[2 * i + 1][r] - mx); }
        sum += (e0[0] + e0[1]) + (e0[2] + e0[3]) + (e1[0] + e1[1]) + (e1[2] + e1[3]);
        wv.x = pk2(e0[0], e0[1]); wv.y = pk2(e0[2], e0[3]); wv.z = pk2(e1[0], e1[1]); wv.w = pk2(e1[2], e1[3]);
        Yp[i] = __builtin_bit_cast(bf16x8, wv); }
    sum += __shfl_xor(sum, 16); sum += __shfl_xor(sum, 32);
    const float inv = 1.0f / sum;
    const bf16_t* vp = MVT + ((size_t)b * 1024 + h * 256 + fr) * 256 + 4 * fq;
    bf16_t* op = Am + row * 1024 + h * 256 + 4 * fq;
#pragma unroll
    for (int dt = 0; dt < 16; ++dt) { f32x4 a = (f32x4){0.f, 0.f, 0.f, 0.f};
#pragma unroll
        for (int i = 0; i < 8; ++i) { const u32x2 lo = *(const u32x2*)(vp + (size_t)dt * 16 * 256 + 32 * i), hi = *(const u32x2*)(vp + (size_t)dt * 16 * 256 + 32 * i + 16);
            u32x4 xv; xv.x = lo.x; xv.y = lo.y; xv.z = hi.x; xv.w = hi.y;
            a = mfma16(__builtin_bit_cast(bf16x8, xv), Yp[i], a); }
        a = a * inv; u32x2 o; o.x = pk2(a[0], a[1]); o.y = pk2(a[2], a[3]); *(u32x2*)(op + 16 * dt) = o; }
}

__device__ __forceinline__ void attn_sample_job(const Params& p, unsigned char* smem, int b) {
    const int tid = threadIdx.x, w = tid >> 6, lane = tid & 63;
    const bf16_t* P = (const bf16_t*)(p.ws + O_P); bf16_t* Am = (bf16_t*)(p.ws + O_AM);
    float* sq = (float*)smem; float* lg = sq + 1024;
    for (int i = tid; i < 1024; i += 512) sq[i] = bf2f(P[(size_t)(NP + b) * LDP + MQ_OFF + i]);
    __syncthreads();
    const float* kc = p.in[3] + (size_t)b * 256 * 1024;
#pragma unroll 4
    for (int rho = w; rho < 1024; rho += 8) { const int hh = rho & 3;
        const f32x4 kv = __builtin_nontemporal_load((const f32x4*)(kc + (size_t)rho * 256) + lane); const f32x4 qv = *(const f32x4*)(sq + hh * 256 + 4 * lane);
        float d = kv[0] * qv[0] + kv[1] * qv[1] + kv[2] * qv[2] + kv[3] * qv[3];
        d = wave_sum(d);
        if (lane == 0) lg[hh * 256 + (rho >> 2)] = d; }
    __syncthreads();
    if (w < 4) { float l[4]; float mx = -3.0e38f;
#pragma unroll
        for (int i = 0; i < 4; ++i) { l[i] = lg[w * 256 + lane + 64 * i]; mx = fmaxf(mx, l[i]); }
        for (int o = 32; o >= 1; o >>= 1) mx = fmaxf(mx, __shfl_xor(mx, o));
        float s = 0.f;
#pragma unroll
        for (int i = 0; i < 4; ++i) { l[i] = __expf(l[i] - mx); s += l[i]; }
        s = wave_sum(s); const float inv = 1.0f / s;
#pragma unroll
        for (int i = 0; i < 4; ++i) lg[w * 256 + lane + 64 * i] = l[i] * inv; }
    __syncthreads();
    const float* vc = p.in[4] + (size_t)b * 256 * 1024;
    for (int cc = 0; cc < 2; ++cc) { const int c = tid + 512 * cc, hh = c >> 8; float a = 0.f;
#pragma unroll 8
        for (int m = 0; m < 256; ++m) a += lg[hh * 256 + m] * __builtin_nontemporal_load(vc + (size_t)m * 1024 + c);
        Am[(size_t)(NP + b) * 1024 + c] = (bf16_t)(pk2(a, 0.f) & 0xffffu); }
    __syncthreads();
}

__device__ __forceinline__ void conv_job(const Params& p, int jc) {
    const int tid = threadIdx.x;
    const bf16_t* P = (const bf16_t*)(p.ws + O_P); bf16_t* Ab = (bf16_t*)(p.ws + O_AB);
    const float* wc = p.in[13];
    for (int i = 0; i < 32; ++i) { const int it = tid + 512 * i, rl = it >> 7, seg = it & 127, c = 8 * seg; const int row = 128 * jc + rl;
        float w0[8], w1[8], w2[8], u0[8], u1[8], u2[8], cb[8];
#pragma unroll
        for (int e = 0; e < 8; ++e) { w0[e] = wc[c + e]; w1[e] = wc[1024 + c + e]; w2[e] = wc[2048 + c + e]; }
        const bf16_t* prow = P + (size_t)row * LDP + c;
        { float a[8], bq[8]; unpack8(*(const u32x4*)(prow + CC_OFF), a); unpack8(*(const u32x4*)(prow + CH_OFF), bq);
#pragma unroll
          for (int e = 0; e < 8; ++e) u2[e] = a[e] * bq[e]; }
        unpack8(*(const u32x4*)(prow + CB_OFF), cb);
        if (row < NP) { const int t = row & 2047, b = row >> 11;
#pragma unroll
            for (int e = 0; e < 8; ++e) { u0[e] = 0.f; u1[e] = 0.f; }
            if (t >= 1) { float a[8], bq[8]; unpack8(*(const u32x4*)(prow - LDP + CC_OFF), a); unpack8(*(const u32x4*)(prow - LDP + CH_OFF), bq);
#pragma unroll
                for (int e = 0; e < 8; ++e) u1[e] = a[e] * bq[e]; }
            if (t >= 2) { float a[8], bq[8]; unpack8(*(const u32x4*)(prow - 2 * LDP + CC_OFF), a); unpack8(*(const u32x4*)(prow - 2 * LDP + CH_OFF), bq);
#pragma unroll
                for (int e = 0; e < 8; ++e) u0[e] = a[e] * bq[e]; }
            if (t >= 2046) { float* so = p.out + OUT_PCONV + (size_t)(b * 2 + (t - 2046)) * 1024 + c;
#pragma unroll
                for (int e = 0; e < 8; ++e) so[e] = u2[e]; }
        } else { const int bs = row - NP; const float* sc = p.in[6] + (size_t)bs * 2048 + c; float* so = p.out + OUT_SCONV + (size_t)bs * 2048 + c;
#pragma unroll
            for (int e = 0; e < 8; ++e) { u0[e] = sc[e]; u1[e] = sc[1024 + e]; so[e] = u1[e]; so[1024 + e] = u2[e]; } }
        float y[8];
#pragma unroll
        for (int e = 0; e < 8; ++e) y[e] = cb[e] * (w0[e] * u0[e] + w1[e] * u1[e] + w2[e] * u2[e]);
        *(u32x4*)(Ab + (size_t)row * 1024 + c) = pack8(y); }
}

__device__ __forceinline__ void phase_gla_norm(const Params& p) {
    const int tid = threadIdx.x, w = tid >> 6, lane = tid & 63;
    const bf16_t* P = (const bf16_t*)(p.ws + O_P); const float* OG = (const float*)(p.ws + O_OG); bf16_t* Aa = (bf16_t*)(p.ws + O_AA);
    const f32x4 g0 = *(const f32x4*)(p.in[11] + 8 * lane), g1 = *(const f32x4*)(p.in[11] + 8 * lane + 4);
    for (int row = blockIdx.x * 8 + w; row < NR; row += gridDim.x * 8) {
#pragma unroll
        for (int h = 0; h < 4; ++h) { const float* op = OG + (size_t)row * D + h * 512 + 8 * lane;
            const f32x4 a = *(const f32x4*)op, b = *(const f32x4*)(op + 4);
            float ss = a[0] * a[0] + a[1] * a[1] + a[2] * a[2] + a[3] * a[3] + b[0] * b[0] + b[1] * b[1] + b[2] * b[2] + b[3] * b[3];
            ss = wave_sum(ss); const float rstd = rsqrtf(ss * (1.0f / 512.0f) + 1e-6f);
            float sg[8]; unpack8(*(const u32x4*)(P + (size_t)row * LDP + G_OFF + h * 512 + 8 * lane), sg);
            float y[8];
#pragma unroll
            for (int e = 0; e < 4; ++e) { y[e] = a[e] * rstd * g0[e] * sg[e]; y[4 + e] = b[e] * rstd * g1[e] * sg[4 + e]; }
            *(u32x4*)(Aa + (size_t)row * D + h * 512 + 8 * lane) = pack8(y); } }
}
template <bool FINAL>
__device__ __forceinline__ void phase_ln(const Params& p, const float* H, const float* gam, const float* bet) {
    const int tid = threadIdx.x, w = tid >> 6, lane = tid & 63;
    float* X1f = (float*)(p.ws + O_X1F); bf16_t* X1b = (bf16_t*)(p.ws + O_X1B);
    for (int row = blockIdx.x * 8 + w; row < NR; row += gridDim.x * 8) {
        f32x4 v[8]; float s = 0.f;
#pragma unroll
        for (int i = 0; i < 8; ++i) { v[i] = *(const f32x4*)(H + (size_t)row * D + 4 * (lane + 64 * i)); s += (v[i][0] + v[i][1]) + (v[i][2] + v[i][3]); }
        const float mu = wave_sum(s) * (1.0f / 2048.0f);
        float q = 0.f;
#pragma unroll
        for (int i = 0; i < 8; ++i) { v[i] = v[i] - mu; q += v[i][0] * v[i][0] + v[i][1] * v[i][1] + v[i][2] * v[i][2] + v[i][3] * v[i][3]; }
        const float rstd = rsqrtf(wave_sum(q) * (1.0f / 2048.0f) + 1e-5f);
        float* orow = FINAL ? (row < NP ? p.out + OUT_YP + (size_t)row * D : p.out + OUT_YS + (size_t)(row - NP) * D) : X1f + (size_t)row * D;
#pragma unroll
        for (int i = 0; i < 8; ++i) { const int c = 4 * (lane + 64 * i);
            const f32x4 y = v[i] * rstd * *(const f32x4*)(gam + c) + *(const f32x4*)(bet + c);
            *(f32x4*)(orow + c) = y;
            if (!FINAL) { u32x2 o; o.x = pk2(y[0], y[1]); o.y = pk2(y[2], y[3]); *(u32x2*)(X1b + (size_t)row * D + c) = o; } } }
}
__device__ __forceinline__ void phase_ffn_mid(const Params& p) {
    const bf16_t* HGU = (const bf16_t*)(p.ws + O_P); bf16_t* Af = (bf16_t*)(p.ws + O_OG);
    const float* wf = p.in[23]; const float* bf = p.in[24];
    const size_t total = (size_t)NR * 688, stride = (size_t)gridDim.x * 512;
    for (size_t it = (size_t)blockIdx.x * 512 + threadIdx.x; it < total; it += stride) { const int row = (int)(it / 688), seg = (int)(it - (size_t)row * 688), c = 8 * seg;
        const bf16_t* hrow = HGU + (size_t)row * NGU + c;
        float h0[8], h1[8], h2[8], hu[8];
        unpack8(*(const u32x4*)hrow, h2); unpack8(*(const u32x4*)(hrow + DFF), hu);
        if (row < NP) { const int t = row & 2047, b = row >> 11;
#pragma unroll
            for (int e = 0; e < 8; ++e) { h0[e] = 0.f; h1[e] = 0.f; }
            if (t >= 1) unpack8(*(const u32x4*)(hrow - NGU), h1);
            if (t >= 2) unpack8(*(const u32x4*)(hrow - 2 * NGU), h0);
            if (t >= 2046) { float* so = p.out + OUT_PFFN + (size_t)(b * 2 + (t - 2046)) * DFF + c;
#pragma unroll
                for (int e = 0; e < 8; ++e) so[e] = h2[e]; }
        } else { const int bs = row - NP; const float* sc = p.in[7] + (size_t)bs * 2 * DFF + c; float* so = p.out + OUT_SFFN + (size_t)bs * 2 * DFF + c;
#pragma unroll
            for (int e = 0; e < 8; ++e) { h0[e] = sc[e]; h1[e] = sc[DFF + e]; so[e] = h1[e]; so[DFF + e] = h2[e]; } }
        float y[8];
#pragma unroll
        for (int e = 0; e < 8; ++e) { const float hc = wf[c + e] * h0[e] + wf[DFF + c + e] * h1[e] + wf[2 * DFF + c + e] * h2[e] + bf[c + e]; y[e] = silu(hc) * hu[e]; }
        *(u32x4*)(Af + (size_t)row * DFF + c) = pack8(y); }
}

__device__ __forceinline__ f32x4 samp_mma(const bf16_t* A, int lda, const bf16_t* Bt, int K, int j) {
    const int tid = threadIdx.x, w = tid >> 6, lane = tid & 63, fr = lane & 15, fq = lane >> 4;
    f32x4 acc[1]; acc[0] = (f32x4){0.f, 0.f, 0.f, 0.f};
    skinny_mma<1, false>(acc, A + (size_t)(NP + 16 * w + fr) * lda + 8 * fq, Bt + (size_t)(16 * j + fr) * K + 8 * fq, 0, K);
    return acc[0];
}

__global__ __launch_bounds__(512, 2) void mega(Params p) {
    extern __shared__ __attribute__((aligned(16))) unsigned char shm[];
    cg::grid_group grid = cg::this_grid();
    PG8_LAS unsigned char* lds = (PG8_LAS unsigned char*)shm;
    unsigned char* ws = p.ws;
    const int G = gridDim.x, bid = blockIdx.x, tid = threadIdx.x, w = tid >> 6, lane = tid & 63, fr = lane & 15, fq = lane >> 4;
    bf16_t* Xb = (bf16_t*)(ws + O_XB); bf16_t* P = (bf16_t*)(ws + O_P);
    pg8::StaticOrder S;

    phase_convert(p, shm);
    grid.sync();

    { S.init(NP, NIN, G, bid); EpiInproj E{P};
      pg8::gemm_phase<EpiInproj, pg8::StaticOrder>(lds, pg8::Gemm{Xb, (const bf16_t*)(ws + O_WIN), NP, NIN, D}, S, E, nullptr); }
    __syncthreads();
    for (int j = bid; j < 256; j += G) p1_sample_inproj(p, j);
    for (int j = bid; j < 256; j += G) p1_memkv(p, j);
    for (int j = bid; j < 130; j += G) p1_alr(p, shm, j);
    grid.sync();

    { int* sjob = (int*)(shm + LDS_BYTES - 64); unsigned* ctr = (unsigned*)(ws + O_CTRL);
      if (bid < 128) gla_prompt_job(p, shm, bid);
      for (;;) {
          __syncthreads();
          if (tid == 0) *sjob = (int)atomicAdd(ctr, 1u);
          __syncthreads();
          const int j = *sjob;
          if (j >= 961) break;
          if (j < 512) gla_sample_job(p, shm, j);
          else if (j < 640) attn_sample_job(p, shm, j - 512);
          else if (j < 896) attn_prompt_job(p, j - 640);
          else conv_job(p, j - 896);
      } }
    grid.sync();

    phase_gla_norm(p);
    grid.sync();

    { float* MGf = (float*)(ws + O_MGF); bf16_t* MGb = (bf16_t*)(ws + O_MGB);
      const bf16_t* Aa = (const bf16_t*)(ws + O_AA); const bf16_t* Ab = (const bf16_t*)(ws + O_AB); const bf16_t* Am = (const bf16_t*)(ws + O_AM);
      const bf16_t* Wgo = (const bf16_t*)(ws + O_WGO); const bf16_t* Wco = (const bf16_t*)(ws + O_WCO); const bf16_t* Wmo = (const bf16_t*)(ws + O_WMO);
      S.init(NP, D, G, bid);
      { EpiMerge E{P, MGf, MGb, ZA_OFF, 0}; pg8::gemm_phase<EpiMerge, pg8::StaticOrder>(lds, pg8::Gemm{Aa, Wgo, NP, D, D}, S, E, nullptr); }
      { EpiMerge E{P, MGf, MGb, ZB_OFF, 1}; pg8::gemm_phase<EpiMerge, pg8::StaticOrder>(lds, pg8::Gemm{Ab, Wco, NP, D, 1024}, S, E, nullptr); }
      { EpiMerge E{P, MGf, MGb, ZM_OFF, 2}; pg8::gemm_phase<EpiMerge, pg8::StaticOrder>(lds, pg8::Gemm{Am, Wmo, NP, D, 1024}, S, E, nullptr); }
      for (int j = bid; j < 128; j += G) { const size_t row = (size_t)NP + 16 * w + fr; const int col = 16 * j + 4 * fq;
          f32x4 tot = (f32x4){0.f, 0.f, 0.f, 0.f};
#pragma unroll
          for (int br = 0; br < 3; ++br) { const f32x4 a = br == 0 ? samp_mma(Aa, D, Wgo, D, j) : br == 1 ? samp_mma(Ab, 1024, Wco, 1024, j) : samp_mma(Am, 1024, Wmo, 1024, j);
              const u32x2 gw = *(const u32x2*)(P + row * LDP + (br == 0 ? ZA_OFF : br == 1 ? ZB_OFF : ZM_OFF) + col);
              f32x4 g; g[0] = bflo(gw.x); g[1] = bfhi(gw.x); g[2] = bflo(gw.y); g[3] = bfhi(gw.y);
              tot = tot + g * a; }
          u32x2 o; o.x = pk2(tot[0], tot[1]); o.y = pk2(tot[2], tot[3]); *(u32x2*)(MGb + row * D + col) = o; } }
    grid.sync();

    { const bf16_t* MGb = (const bf16_t*)(ws + O_MGB); const bf16_t* Wo = (const bf16_t*)(ws + O_WO); float* H1 = (float*)(ws + O_H1);
      S.init(NP, D, G, bid);
      { EpiResid E{p.in[0], H1}; pg8::gemm_phase<EpiResid, pg8::StaticOrder>(lds, pg8::Gemm{MGb, Wo, NP, D, D}, S, E, nullptr); }
      for (int j = bid; j < 128; j += G) { const f32x4 a = samp_mma(MGb, D, Wo, D, j); const int r = 16 * w + fr, col = 16 * j + 4 * fq;
          *(f32x4*)(H1 + (size_t)(NP + r) * D + col) = *(const f32x4*)(p.in[1] + (size_t)r * D + col) * DN_ALPHA + a; } }
    grid.sync();

    phase_ln<false>(p, (const float*)(ws + O_H1), p.in[19], p.in[20]);
    grid.sync();

    { S.init(NRP, NGU, G, bid); EpiBf16 E{P, NGU};
      pg8::gemm_phase<EpiBf16, pg8::StaticOrder>(lds, pg8::Gemm{(const bf16_t*)(ws + O_X1B), (const bf16_t*)(ws + O_WGU), NRP, NGU, D}, S, E, nullptr); }
    grid.sync();

    phase_ffn_mid(p);
    grid.sync();

    { const bf16_t* Af = (const bf16_t*)(ws + O_OG); const bf16_t* Wd = (const bf16_t*)(ws + O_WD); const float* X1f = (const float*)(ws + O_X1F); float* H2 = (float*)(ws + O_H1);
      S.init(NP, D, G, bid);
      { EpiResid E{X1f, H2}; pg8::gemm_phase<EpiResid, pg8::StaticOrder>(lds, pg8::Gemm{Af, Wd, NP, D, DFF}, S, E, nullptr); }
      for (int j = bid; j < 128; j += G) { const f32x4 a = samp_mma(Af, DFF, Wd, DFF, j); const size_t o = (size_t)(NP + 16 * w + fr) * D + 16 * j + 4 * fq;
          *(f32x4*)(H2 + o) = *(const f32x4*)(X1f + o) * DN_ALPHA + a; } }
    grid.sync();

    phase_ln<true>(p, (const float*)(ws + O_H1), p.in[26], p.in[27]);
}

extern "C" void kernel_launch(void* const* d_in, const int* in_sizes, int n_in, void* d_out, int out_size, void* d_ws, size_t ws_size, hipStream_t stream) {
    static int grid_blocks = 0;
    if (!grid_blocks) {
        int dev = 0, cus = 0, per_cu = 0;
        (void)hipGetDevice(&dev);
        (void)hipDeviceGetAttribute(&cus, hipDeviceAttributeMultiprocessorCount, dev);
        (void)hipFuncSetAttribute((const void*)mega, hipFuncAttributeMaxDynamicSharedMemorySize, LDS_BYTES);
        (void)hipOccupancyMaxActiveBlocksPerMultiprocessor(&per_cu, mega, 512, LDS_BYTES);
        if (per_cu > 1) per_cu = 1;
        grid_blocks = cus * per_cu;
        if (grid_blocks <= 0) { fprintf(stderr, "occupancy query returned 0 (cus %d per_cu %d)\n", cus, per_cu); grid_blocks = cus > 0 ? cus : 256; }
    }
    Params p; memset(&p, 0, sizeof(p));
    for (int i = 0; i < 28; ++i) p.in[i] = (const float*)d_in[i];
    p.out = (float*)d_out; p.ws = (unsigned char*)d_ws;
    unsigned char* ws = (unsigned char*)d_ws;
    (void)hipMemsetAsync(ws + O_CTRL, 0, 4096, stream);
    void* args[] = {&p};
    hipError_t e = hipLaunchCooperativeKernel((const void*)mega, dim3(grid_blocks), dim3(512), args, LDS_BYTES, stream);
    if (e != hipSuccess) fprintf(stderr, "cooperative launch failed: %s (grid %d)\n", hipGetErrorString(e), grid_blocks);
}
```

```cpp
#include <hip/hip_runtime.h>
#include <hip/hip_cooperative_groups.h>
#include <cstdio>
#include <cstring>
namespace cg = cooperative_groups;

namespace pg8 {
#define PG8_LAS __attribute__((address_space(3)))
typedef unsigned short bf16_t;
typedef short bf16x8 __attribute__((ext_vector_type(8)));
typedef float f32x4 __attribute__((ext_vector_type(4)));
typedef unsigned u32x4 __attribute__((ext_vector_type(4)));
typedef unsigned u32x2 __attribute__((ext_vector_type(2)));
constexpr int BM = 256, BK = 64, HALF = 128, HTB = HALF * BK * 2, STAGE_BYTES = 8 * HTB, NXCD = 8, WGM = 8;
__host__ __device__ __forceinline__ int lds_byte(int r, int c) { const int st = (r >> 4) * 2 + (c >> 5), rr = r & 15, cc = c & 31, ob = rr * 64 + cc * 2; return st * 1024 + (ob ^ (((ob >> 9) & 1) << 5)); }
__host__ __device__ __forceinline__ void stage_rc(int b, int& R, int& C) { const int st = b / 1024, sb = b % 1024, swz = sb ^ (((sb >> 9) & 1) << 5); R = (st >> 1) * 16 + swz / 64; C = (st & 1) * 32 + (swz % 64) / 2; }
__host__ __device__ __forceinline__ int perm32(int rho) { const int n = rho >> 4, i = rho & 15; return 8 * (i >> 2) + 4 * n + (i & 3); }
struct Unit { int pm, pn; };
struct Gemm { const bf16_t* A; const bf16_t* Bt; int M, N, K; };
struct StaticOrder {
    int nM, nN, nwg, G, c, reps;
    __host__ __device__ void init(int M, int N, int G_, int c_, int reps_ = 1) { nM = M / BM; nN = N / BM; nwg = nM * nN; G = G_; c = c_; reps = reps_; }
    __host__ __device__ bool next(int i, Unit& u) const {
        const long L = (long)i * G + c; if (L >= (long)nwg * reps) return false;
        int wgid = (int)(L % nwg); { const int q = nwg / NXCD, r = nwg % NXCD, xcd = wgid % NXCD, off = wgid / NXCD; wgid = (xcd < r ? xcd * (q + 1) : r * (q + 1) + (xcd - r) * q) + off; }
        const int nig = WGM * nN, gid = wgid / nig, fm = gid * WGM, gsz = (nM - fm) < WGM ? (nM - fm) : WGM;
        u.pm = fm + ((wgid % nig) % gsz); u.pn = (wgid % nig) / gsz; return true;
    }
    __device__ __forceinline__ void a_ready(const Unit&) const {}
    __device__ __forceinline__ void done(const Unit&) const {}
};
__device__ __forceinline__ unsigned cvt_pk_bf16(float lo, float hi) { unsigned r; asm volatile("v_cvt_pk_bf16_f32 %0, %1, %2" : "=v"(r) : "v"(lo), "v"(hi)); return r; }

template <class Epi, class Sched, bool STAMP = false>
__device__ __forceinline__ void gemm_phase(PG8_LAS unsigned char* lds, const Gemm g, const Sched& S, const Epi& E, unsigned long long* stamps) {
    const int tid = threadIdx.x, wid = __builtin_amdgcn_readfirstlane(tid >> 6), lane = tid & 63, wr = wid >> 2, wc = wid & 3, fr = lane & 15, fq = lane >> 4;
    const int K = g.K, nt = K / BK;
    int ts_lo = 0, ts_hi = 0, nts = 0; const unsigned long long rt_entry = STAMP ? (unsigned long long)wall_clock64() : 0ull;
#define PG8_STAMP() do { if (STAMP && wid == 0 && nts < 64) { const unsigned long long _c = (unsigned long long)clock64(); \
        ts_lo = (lane == nts) ? (int)(unsigned)_c : ts_lo; ts_hi = (lane == nts) ? (int)(unsigned)(_c >> 32) : ts_hi; ++nts; } } while (0)
    PG8_STAMP();
    unsigned voffA[2], voffB[2];
#pragma unroll
    for (int i = 0; i < 2; ++i) { int R, C; stage_rc(tid * 16 + i * 8192, R, C); const int Rb = Epi::PERM ? ((R & ~31) + perm32(R & 31)) : R;
        voffA[i] = (unsigned)(R * K + C) * 2u; voffB[i] = (unsigned)(Rb * K + C) * 2u; }
    const size_t kstep = (size_t)(BK * 2);
    const size_t hstep = (size_t)HALF * K * 2;
    const size_t tstep = 2 * hstep;
    const unsigned ldsw = (unsigned)wid * 1024u;
    const int aoff = lds_byte(wr * 64 + fr, fq * 8), boff = lds_byte(wc * 32 + fr, fq * 8);
#define PG8_SA(b, h) (((b) * 2 + (h)) * HTB)
#define PG8_SB(b, h) ((4 + (b) * 2 + (h)) * HTB)
#define PG8_STAGE(bufoff, gbase, voff) do { _Pragma("unroll") for (int _i = 0; _i < 2; ++_i) \
        __builtin_amdgcn_global_load_lds((const unsigned*)((const char*)(gbase) + (voff)[_i]), (PG8_LAS unsigned*)(lds + (bufoff) + ldsw + _i * 8192), 16, 0, 0); } while (0)
#define PG8_LDA(dst, b, h) do { _Pragma("unroll") for (int m = 0; m < 4; ++m) _Pragma("unroll") for (int k = 0; k < 2; ++k) dst[m][k] = *(const PG8_LAS bf16x8*)(lds + PG8_SA(b, h) + aoff + m * 2048 + k * 1024); } while (0)
#define PG8_LDB(dst, b, h) do { _Pragma("unroll") for (int n = 0; n < 2; ++n) _Pragma("unroll") for (int k = 0; k < 2; ++k) dst[n][k] = *(const PG8_LAS bf16x8*)(lds + PG8_SB(b, h) + boff + n * 2048 + k * 1024); } while (0)
#define PG8_MMA(ai, bj, At, Bt) do { __builtin_amdgcn_s_setprio(1); _Pragma("unroll") for (int m = 0; m < 4; ++m) _Pragma("unroll") for (int n = 0; n < 2; ++n) _Pragma("unroll") for (int k = 0; k < 2; ++k) \
        acc[ai][bj][m][n] = __builtin_amdgcn_mfma_f32_16x16x32_bf16(Bt[n][k], At[m][k], acc[ai][bj][m][n], 0, 0, 0); __builtin_amdgcn_s_setprio(0); } while (0)
#define PG8_WAIT_V(n) asm volatile("s_waitcnt vmcnt(" #n ")" ::: "memory")
#define PG8_WAIT_L(n) asm volatile("s_waitcnt lgkmcnt(" #n ")" ::: "memory")
#define PG8_BAR __builtin_amdgcn_s_barrier()
#define PG8_SCHED __builtin_amdgcn_sched_barrier(0)
    Unit cur, nxt; int ui = 0;
    if (!S.next(0, cur)) return;
    f32x4 acc[2][2][4][2];
#pragma unroll
    for (int a = 0; a < 2; ++a)
#pragma unroll
        for (int b = 0; b < 2; ++b)
#pragma unroll
            for (int m = 0; m < 4; ++m)
#pragma unroll
                for (int n = 0; n < 2; ++n) acc[a][b][m][n] = (f32x4){0.f, 0.f, 0.f, 0.f};
    bf16x8 At[4][2], B0[2][2], B1[2][2];
    const char* cA = (const char*)g.A + (size_t)cur.pm * tstep; const char* cB = (const char*)g.Bt + (size_t)cur.pn * tstep;
    S.a_ready(cur);
    PG8_STAGE(PG8_SB(0, 0), cB, voffB); PG8_STAGE(PG8_SA(0, 0), cA, voffA); PG8_STAGE(PG8_SB(0, 1), cB + hstep, voffB); PG8_STAGE(PG8_SA(0, 1), cA + hstep, voffA);
    if (wr == 1) PG8_BAR;
    PG8_WAIT_V(4); PG8_BAR;
    PG8_STAGE(PG8_SB(1, 0), cB + kstep, voffB); PG8_STAGE(PG8_SA(1, 0), cA + kstep, voffA); PG8_STAGE(PG8_SB(1, 1), cB + hstep + kstep, voffB);
    PG8_WAIT_V(6); PG8_BAR;
    PG8_STAMP();
    for (;;) {
        const bool has_next = S.next(ui + 1, nxt);
        const char* nA = has_next ? (const char*)g.A + (size_t)nxt.pm * tstep : cA; const char* nB = has_next ? (const char*)g.Bt + (size_t)nxt.pn * tstep : cB;
        for (int t = 0; t < nt; t += 2) {
            const bool last = (t == nt - 2);
            const char* a1 = cA + (size_t)(t + 1) * kstep;
            const char* a2 = last ? nA : cA + (size_t)(t + 2) * kstep; const char* b2 = last ? nB : cB + (size_t)(t + 2) * kstep;
            const char* a3 = a2 + kstep; const char* b3 = b2 + kstep;
            if (last && has_next) S.a_ready(nxt);
            PG8_LDB(B0, 0, 0); PG8_SCHED; PG8_LDA(At, 0, 0); PG8_STAGE(PG8_SA(1, 1), a1 + hstep, voffA);
            PG8_WAIT_L(8); PG8_BAR; PG8_WAIT_L(0); PG8_MMA(0, 0, At, B0); PG8_BAR; PG8_SCHED;
            PG8_LDB(B1, 0, 1); PG8_STAGE(PG8_SB(0, 0), b2, voffB);
            PG8_BAR; PG8_WAIT_L(0); PG8_MMA(0, 1, At, B1); PG8_BAR;
            PG8_LDA(At, 0, 1); PG8_STAGE(PG8_SA(0, 0), a2, voffA);
            PG8_BAR; PG8_WAIT_L(0); PG8_MMA(1, 0, At, B0); PG8_BAR; PG8_SCHED;
            PG8_STAGE(PG8_SB(0, 1), b2 + hstep, voffB);
            PG8_WAIT_V(6); PG8_BAR; PG8_MMA(1, 1, At, B1); PG8_BAR;
            PG8_LDB(B0, 1, 0); PG8_SCHED; PG8_LDA(At, 1, 0); PG8_STAGE(PG8_SA(0, 1), a2 + hstep, voffA);
            PG8_WAIT_L(8); PG8_BAR; PG8_WAIT_L(0); PG8_MMA(0, 0, At, B0); PG8_BAR; PG8_SCHED;
            PG8_LDB(B1, 1, 1); PG8_STAGE(PG8_SB(1, 0), b3, voffB);
            PG8_BAR; PG8_WAIT_L(0); PG8_MMA(0, 1, At, B1); PG8_BAR;
            PG8_LDA(At, 1, 1); PG8_STAGE(PG8_SA(1, 0), a3, voffA);
            PG8_BAR; PG8_WAIT_L(0); PG8_MMA(1, 0, At, B0); PG8_BAR; PG8_SCHED;
            PG8_STAGE(PG8_SB(1, 1), b3 + hstep, voffB);
            PG8_WAIT_V(6); PG8_BAR; PG8_MMA(1, 1, At, B1); PG8_BAR;
        }
        PG8_STAMP();
        if constexpr (!Epi::AFTER_DRAIN) { E(acc, cur, wr, wc, fr, fq); S.done(cur); }
        PG8_STAMP();
        if (!has_next) break;
#pragma unroll
        for (int a = 0; a < 2; ++a)
#pragma unroll
            for (int b = 0; b < 2; ++b)
#pragma unroll
                for (int m = 0; m < 4; ++m)
#pragma unroll
                    for (int n = 0; n < 2; ++n) acc[a][b][m][n] = (f32x4){0.f, 0.f, 0.f, 0.f};
        cur = nxt; cA = nA; cB = nB; ++ui;
    }
    PG8_WAIT_V(0);
    if (wr == 0) PG8_BAR;
    PG8_BAR;
    if constexpr (Epi::AFTER_DRAIN) { E.fused(acc, cur, wr, wc, fr, fq, lds, wid, lane); S.done(cur); }
    PG8_STAMP();
    if (STAMP && wid == 0) { stamps[lane] = lane < nts ? (((unsigned long long)(unsigned)ts_hi << 32) | (unsigned)ts_lo) : 0ull;
        if (lane == 62) stamps[62] = rt_entry; if (lane == 63) stamps[63] = (unsigned long long)wall_clock64(); }
#undef PG8_STAMP
#undef PG8_SA
#undef PG8_SB
#undef PG8_STAGE
#undef PG8_LDA
#undef PG8_LDB
#undef PG8_MMA
#undef PG8_WAIT_V
#undef PG8_WAIT_L
#undef PG8_BAR
#undef PG8_SCHED
}
}

using pg8::bf16_t; using pg8::bf16x8; using pg8::f32x4; using pg8::u32x4; using pg8::u32x2;

constexpr int D = 2048, NP = 8192, NS = 128, NR = 8320, NRP = 8448;
constexpr int NIN = 16384, LDP = 16384 + 64, WIN_LD = 16400;
constexpr int DFF = 5504, NGU = 11008;
constexpr int Q_OFF = 0, K_OFF = 1024, V_OFF = 2048, G_OFF = 4096, CB_OFF = 6144, CC_OFF = 7168, CH_OFF = 8192, MQ_OFF = 9216, ZA_OFF = 10240, ZB_OFF = 12288, ZM_OFF = 14336;
constexpr float DN_ALPHA = 1.189207115002721f;
constexpr int LDS_BYTES = 158 * 1024;
#ifndef PROBE
#define PROBE 0
#endif
constexpr int REP_P0 = (PROBE == 1) ? 2 : 1, REP_P2 = (PROBE == 2) ? 2 : 1, REP_SK = (PROBE == 3) ? 2 : 1, REP_P7 = (PROBE == 4) ? 2 : 1, REP_GLA = (PROBE == 5) ? 2 : 1, REP_P6 = (PROBE == 7) ? 2 : 1, REP_P1 = (PROBE == 8) ? 2 : 1, REP_SYNC = (PROBE == 9) ? 11 : 1;

constexpr size_t O_CTRL = 0;
constexpr size_t O_XB   = 32768;
constexpr size_t O_MEMB = O_XB + (size_t)NRP * D * 2;
constexpr size_t O_WIN  = O_MEMB + (size_t)1024 * D * 2;
constexpr size_t O_WALR = O_WIN + (size_t)NIN * D * 2;
constexpr size_t O_WGO  = O_WALR + (size_t)16 * D * 2;
constexpr size_t O_WCO  = O_WGO + (size_t)D * D * 2;
constexpr size_t O_WMO  = O_WCO + (size_t)D * 1024 * 2;
constexpr size_t O_WO   = O_WMO + (size_t)D * 1024 * 2;
constexpr size_t O_WMKV = O_WO + (size_t)D * D * 2;
constexpr size_t O_WGU  = O_WMKV + (size_t)D * D * 2;
constexpr size_t O_WD   = O_WGU + (size_t)NGU * D * 2;
constexpr size_t O_P    = O_WD + (size_t)D * DFF * 2;
constexpr size_t O_BC   = O_P + (size_t)NR * LDP * 2;
constexpr size_t O_MKB  = O_BC + (size_t)NR * 1024 * 4;
constexpr size_t O_MVT  = O_MKB + (size_t)1024 * 1024 * 2;
constexpr size_t O_OG   = O_MVT + (size_t)1024 * 1024 * 2;
constexpr size_t O_MGF  = O_OG + (size_t)NR * D * 4;
constexpr size_t O_AA   = O_MGF + (size_t)NP * D * 4;
constexpr size_t O_AB   = O_AA + (size_t)NR * D * 2;
constexpr size_t O_AM   = O_AB + (size_t)NR * 1024 * 2;
constexpr size_t O_MGB  = O_AM + (size_t)NR * 1024 * 2;
constexpr size_t O_H1   = O_MGB + (size_t)NR * D * 2;
constexpr size_t O_X1F  = O_H1 + (size_t)NR * D * 4;
constexpr size_t O_X1B  = O_X1F + (size_t)NR * D * 4;
constexpr size_t WS_TOTAL = O_X1B + (size_t)NRP * D * 2;
static_assert(WS_TOTAL <= (size_t)1073741824, "workspace too large");
static_assert((size_t)NRP * NGU * 2 <= (size_t)NR * LDP * 2, "HGU alias");
static_assert((size_t)NR * DFF * 2 <= (size_t)NR * D * 4 + (size_t)NP * D * 4, "A_ffn alias");

constexpr size_t OUT_YP = 0;
constexpr size_t OUT_YS = OUT_YP + (size_t)NP * D;
constexpr size_t OUT_PMK = OUT_YS + (size_t)NS * D;
constexpr size_t OUT_PMV = OUT_PMK + (size_t)1024 * 1024;
constexpr size_t OUT_PGLA = OUT_PMV + (size_t)1024 * 1024;
constexpr size_t OUT_PCONV = OUT_PGLA + (size_t)4 * 4 * 256 * 512;
constexpr size_t OUT_PFFN = OUT_PCONV + (size_t)4 * 2 * 1024;
constexpr size_t OUT_SGLA = OUT_PFFN + (size_t)4 * 2 * DFF;
constexpr size_t OUT_SCONV = OUT_SGLA + (size_t)NS * 4 * 256 * 512;
constexpr size_t OUT_SFFN = OUT_SCONV + (size_t)NS * 2 * 1024;

struct Params {
    const float* in[28];
    float* out;
    unsigned char* ws;
};
constexpr int TB1 = 768, TB2 = 2048, TB3 = 2304, TB4 = 2432, TB5 = 2560, TB6 = 2688, TB7 = 2816, TB8 = 3072, TB9 = 3760, TB10 = 4448, NTILES = 5136;

typedef __bf16 bf16x2_t __attribute__((ext_vector_type(2)));
typedef float f32x2_t __attribute__((ext_vector_type(2)));
__device__ __forceinline__ unsigned pk2(float lo, float hi) { f32x2_t v = {lo, hi}; bf16x2_t b = __builtin_convertvector(v, bf16x2_t); return __builtin_bit_cast(unsigned, b); }
__device__ __forceinline__ float bflo(unsigned w) { return __uint_as_float(w << 16); }
__device__ __forceinline__ float bfhi(unsigned w) { return __uint_as_float(w & 0xffff0000u); }
__device__ __forceinline__ float bf2f(bf16_t b) { return __uint_as_float(((unsigned)b) << 16); }
__device__ __forceinline__ float sigm(float x) { return __builtin_amdgcn_rcpf(1.0f + __expf(-x)); }
__device__ __forceinline__ float silu(float x) { return x * __builtin_amdgcn_rcpf(1.0f + __expf(-x)); }
__device__ __forceinline__ int otid() { int t = threadIdx.x; asm volatile("" : "+v"(t)); return t; }
__device__ __forceinline__ float wave_sum(float v) { for (int o = 32; o >= 1; o >>= 1) v += __shfl_xor(v, o); return v; }
__device__ __forceinline__ f32x4 mfma16(bf16x8 x, bf16x8 y, f32x4 c) { return __builtin_amdgcn_mfma_f32_16x16x32_bf16(x, y, c, 0, 0, 0); }
__device__ __forceinline__ bf16x8 ld8(const bf16_t* p) { return *(const bf16x8*)p; }
__device__ __forceinline__ void unpack8(u32x4 w, float (&f)[8]) { f[0] = bflo(w.x); f[1] = bfhi(w.x); f[2] = bflo(w.y); f[3] = bfhi(w.y); f[4] = bflo(w.z); f[5] = bfhi(w.z); f[6] = bflo(w.w); f[7] = bfhi(w.w); }
__device__ __forceinline__ u32x4 pack8(const float (&f)[8]) { u32x4 w; w.x = pk2(f[0], f[1]); w.y = pk2(f[2], f[3]); w.z = pk2(f[4], f[5]); w.w = pk2(f[6], f[7]); return w; }

__device__ __forceinline__ int inproj_mode(int col) { return col < 1024 ? 1 : col < 4096 ? 0 : col < 6144 ? 2 : col < 9216 ? 0 : col < 10240 ? 1 : 3; }
__device__ __forceinline__ f32x4 inproj_act(f32x4 v, int mode) {
    if (mode == 1) { v = v * 0.0625f; }
    else if (mode == 2) { v[0] = silu(v[0]); v[1] = silu(v[1]); v[2] = silu(v[2]); v[3] = silu(v[3]); }
    else if (mode == 3) { v[0] = sigm(v[0]); v[1] = sigm(v[1]); v[2] = sigm(v[2]); v[3] = sigm(v[3]); }
    return v;
}

#define XB_TMO      128
#define XB_XCNT(j)  (256  + 64 * (j))
#define XB_XSUB(j)  (1280 + 64 * (j))
#define XB_XGEN(j)  (2304 + 64 * (j))
#define XB_TOP      3328
#define XB_TOPGEN   3392
#define XCD_BAR_WORDS 3456
#define XB_SPIN_CAP (1u << 18)
#define LAS __attribute__((address_space(3)))

__device__ __forceinline__ unsigned xb_ld(unsigned* p)              { return __hip_atomic_load(p, __ATOMIC_RELAXED, __HIP_MEMORY_SCOPE_AGENT); }
__device__ __forceinline__ unsigned xb_add(unsigned* p, unsigned v) { return __hip_atomic_fetch_add(p, v, __ATOMIC_RELAXED, __HIP_MEMORY_SCOPE_AGENT); }
__device__ __forceinline__ unsigned xb_xcc_id() { return (unsigned)__builtin_amdgcn_s_getreg((3 << 11) | 20) & 0xFu; }
#define XB_SPIN(cond, bar) do { unsigned _sp = 0; while (cond) { __builtin_amdgcn_s_sleep(1); \
    if ((++_sp & 255u) == 0u) { if (xb_ld(&(bar)[XB_TMO])) break; if (_sp > XB_SPIN_CAP) { atomicAdd(&(bar)[XB_TMO], 1u); break; } } } } while (0)

struct XcdBarrier {
    unsigned* bar; unsigned x;
    volatile LAS unsigned* st;
};

__device__ __forceinline__ XcdBarrier xcd_barrier_post(unsigned* bar, volatile LAS unsigned* st) {
    XcdBarrier b; b.bar = bar; b.x = xb_xcc_id(); b.st = st;
    if (threadIdx.x == 0) (void)xb_add(&bar[XB_XCNT(b.x)], 1u);
    return b;
}
__device__ __forceinline__ void xcd_barrier_complete(unsigned* bar, unsigned x, unsigned& nloc, unsigned& nx) {
    const unsigned G = gridDim.x * gridDim.y * gridDim.z;
    unsigned sum, cnt, mine, sp = 0u;
    for (;;) {
        sum = 0u; cnt = 0u; mine = 0u;
#pragma unroll
        for (unsigned j = 0; j < 16; ++j) { const unsigned c = xb_ld(&bar[XB_XCNT(j)]); sum += c; cnt += (c > 0u) ? 1u : 0u; mine = (j == x) ? c : mine; }
        if (sum == G) break;
        __builtin_amdgcn_s_sleep(1);
        if ((++sp & 255u) == 0u) { if (xb_ld(&bar[XB_TMO])) break; if (sp > XB_SPIN_CAP) { atomicAdd(&bar[XB_TMO], 1u); break; } }
    }
    nloc = mine > 0u ? mine : 1u; nx = cnt > 0u ? cnt : 1u;
}

__device__ __forceinline__ void xcd_barrier(const XcdBarrier& b) {
    asm volatile("s_waitcnt vmcnt(0)" ::: "memory");
    __syncthreads();
    if (threadIdx.x == 0) {
        unsigned* bar = b.bar;
        __builtin_amdgcn_s_waitcnt(0);
        unsigned nloc = b.st[0], nx = b.st[1];
        if (nloc == 0u) { xcd_barrier_complete(bar, b.x, nloc, nx); b.st[0] = nloc; b.st[1] = nx; }
        const unsigned old = xb_add(&bar[XB_XSUB(b.x)], 1u);
        const unsigned gen = old / nloc;
        if (old + 1u == (gen + 1u) * nloc) {
            __builtin_amdgcn_fence(__ATOMIC_RELEASE, "agent");
            asm volatile("s_waitcnt vmcnt(0)" ::: "memory");
            const unsigned og = xb_add(&bar[XB_TOP], 1u);
            const unsigned tg = og / nx;
            if (og + 1u == (tg + 1u) * nx) xb_add(&bar[XB_TOPGEN], 1u);
            else XB_SPIN(xb_ld(&bar[XB_TOPGEN]) == tg, bar);
            __builtin_amdgcn_fence(__ATOMIC_ACQUIRE, "agent");
            xb_add(&bar[XB_XGEN(b.x)], 1u);
            asm volatile("s_waitcnt vmcnt(0)" ::: "memory");
        } else {
            XB_SPIN(xb_ld(&bar[XB_XGEN(b.x)]) == gen, bar);
            __builtin_amdgcn_fence(__ATOMIC_ACQUIRE, "agent");
            asm volatile("s_waitcnt vmcnt(0)" ::: "memory");
        }
    }
    __syncthreads();
}

struct EpiInproj {
    static constexpr bool PERM = true, AFTER_DRAIN = false;
    bf16_t* O;
    __device__ __forceinline__ void operator()(const f32x4 (&acc)[2][2][4][2], const pg8::Unit& u, int wr, int wc, int fr, int fq) const {
        const int mode = inproj_mode(u.pn * 256);
        const float ca = mode == 0 ? 1.0f : mode == 1 ? 0.0625f : 0.0f, cb = mode == 3 ? 1.0f : 0.0f, cc = mode == 2 ? 1.0f : 0.0f;
        bf16_t* base = O + (size_t)(u.pm * 256 + wr * 64 + fr) * LDP + u.pn * 256 + wc * 32 + 8 * fq;
#pragma unroll
        for (int ai = 0; ai < 2; ++ai)
#pragma unroll
            for (int m = 0; m < 4; ++m) { bf16_t* rowp = base + (size_t)(ai * 128 + m * 16) * LDP;
#pragma unroll
                for (int bj = 0; bj < 2; ++bj) { float y[8];
#pragma unroll
                    for (int e = 0; e < 8; ++e) { const float x = e < 4 ? acc[ai][bj][m][0][e & 3] : acc[ai][bj][m][1][e & 3];
                        const float sg = __builtin_amdgcn_rcpf(1.0f + __expf(-x));
                        y[e] = ca * x + sg * (cb + cc * x); }
                    __builtin_nontemporal_store(pack8(y), (u32x4*)(rowp + bj * 128)); } }
    }
};
struct EpiBf16 {
    static constexpr bool PERM = true, AFTER_DRAIN = false;
    bf16_t* O; int ldc;
    __device__ __forceinline__ void operator()(const f32x4 (&acc)[2][2][4][2], const pg8::Unit& u, int wr, int wc, int fr, int fq) const {
        const int row0 = u.pm * 256 + wr * 64 + fr, col0 = u.pn * 256 + wc * 32 + 8 * fq;
#pragma unroll
        for (int ai = 0; ai < 2; ++ai)
#pragma unroll
            for (int m = 0; m < 4; ++m) { bf16_t* rowp = O + (size_t)(row0 + ai * 128 + m * 16) * ldc + col0;
#pragma unroll
                for (int bj = 0; bj < 2; ++bj) { const f32x4 v0 = acc[ai][bj][m][0], v1 = acc[ai][bj][m][1];
                    u32x4 w; w.x = pk2(v0[0], v0[1]); w.y = pk2(v0[2], v0[3]); w.z = pk2(v1[0], v1[1]); w.w = pk2(v1[2], v1[3]);
                    *(u32x4*)(rowp + bj * 128) = w; } }
    }
};
struct EpiMerge {
    static constexpr bool PERM = true, AFTER_DRAIN = false;
    const bf16_t* P; float* MGf; bf16_t* MGb; int zoff, mode;
    __device__ __forceinline__ void operator()(const f32x4 (&acc)[2][2][4][2], const pg8::Unit& u, int wr, int wc, int fr, int fq) const {
        const int row0 = u.pm * 256 + wr * 64 + fr, col0 = u.pn * 256 + wc * 32 + 8 * fq;
#pragma unroll
        for (int ai = 0; ai < 2; ++ai)
#pragma unroll
            for (int m = 0; m < 4; ++m) { const size_t row = (size_t)(row0 + ai * 128 + m * 16);
#pragma unroll
                for (int bj = 0; bj < 2; ++bj) { const int col = col0 + bj * 128;
                    float g[8], v[8]; unpack8(*(const u32x4*)(P + row * LDP + zoff + col), g);
#pragma unroll
                    for (int e = 0; e < 4; ++e) { v[e] = g[e] * acc[ai][bj][m][0][e]; v[4 + e] = g[4 + e] * acc[ai][bj][m][1][e]; }
                    bf16_t* mp = MGb + row * D + col;
                    if (mode != 0) { float pv[8]; unpack8(*(const u32x4*)mp, pv);
#pragma unroll
                        for (int e = 0; e < 8; ++e) v[e] += pv[e]; }
                    *(u32x4*)mp = pack8(v); } }
    }
};
struct EpiResid {
    static constexpr bool PERM = false, AFTER_DRAIN = false;
    const float* resid; bf16_t* out;
    __device__ __forceinline__ void operator()(const f32x4 (&acc)[2][2][4][2], const pg8::Unit& u, int wr, int wc, int fr, int fq) const {
        const int row0 = u.pm * 256 + wr * 64 + fr, col0 = u.pn * 256 + wc * 32 + 4 * fq;
#pragma unroll
        for (int ai = 0; ai < 2; ++ai)
#pragma unroll
            for (int m = 0; m < 4; ++m) { const size_t ro = (size_t)(row0 + ai * 128 + m * 16) * D + col0;
#pragma unroll
                for (int bj = 0; bj < 2; ++bj)
#pragma unroll
                    for (int n = 0; n < 2; ++n) { const size_t o = ro + bj * 128 + n * 16;
                        const f32x4 y = *(const f32x4*)(resid + o) * DN_ALPHA + acc[ai][bj][m][n];
                        u32x2 w; w.x = pk2(y[0], y[1]); w.y = pk2(y[2], y[3]); *(u32x2*)(out + o) = w; } }
    }
};

struct EpiResidB {
    static constexpr bool PERM = true, AFTER_DRAIN = false;
    const bf16_t* resid; bf16_t* out;
    __device__ __forceinline__ void operator()(const f32x4 (&acc)[2][2][4][2], const pg8::Unit& u, int wr, int wc, int fr, int fq) const {
        const int row0 = u.pm * 256 + wr * 64 + fr, col0 = u.pn * 256 + wc * 32 + 8 * fq;
#pragma unroll
        for (int ai = 0; ai < 2; ++ai)
#pragma unroll
            for (int m = 0; m < 4; ++m) { const size_t ro = (size_t)(row0 + ai * 128 + m * 16) * D + col0;
#pragma unroll
                for (int bj = 0; bj < 2; ++bj) { const size_t o = ro + bj * 128;
                    float r[8], y[8]; unpack8(*(const u32x4*)(resid + o), r);
#pragma unroll
                    for (int e = 0; e < 4; ++e) { y[e] = r[e] * DN_ALPHA + acc[ai][bj][m][0][e]; y[4 + e] = r[4 + e] * DN_ALPHA + acc[ai][bj][m][1][e]; }
                    *(u32x4*)(out + o) = pack8(y); } }
    }
};
template <int RT, int CT, bool SWAP, int UNR = 2>
__device__ __forceinline__ void sk_mma(f32x4 (&acc)[RT][CT], const bf16_t* ap, size_t astep, const bf16_t* bp, size_t bstep, int ks0, int ks1) {
    int ks = ks0;
    for (; ks + UNR <= ks1; ks += UNR) {
        bf16x8 a[UNR][RT], b[UNR][CT];
#pragma unroll
        for (int u = 0; u < UNR; ++u) {
#pragma unroll
            for (int r = 0; r < RT; ++r) a[u][r] = ld8(ap + r * astep + 32 * (ks + u));
#pragma unroll
            for (int c = 0; c < CT; ++c) b[u][c] = ld8(bp + c * bstep + 32 * (ks + u)); }
#pragma unroll
        for (int u = 0; u < UNR; ++u)
#pragma unroll
            for (int r = 0; r < RT; ++r)
#pragma unroll
                for (int c = 0; c < CT; ++c) acc[r][c] = SWAP ? mfma16(a[u][r], b[u][c], acc[r][c]) : mfma16(b[u][c], a[u][r], acc[r][c]);
    }
    if (UNR > 2 && ks + 2 <= ks1) {
        bf16x8 a[2][RT], b[2][CT];
#pragma unroll
        for (int u = 0; u < 2; ++u) {
#pragma unroll
            for (int r = 0; r < RT; ++r) a[u][r] = ld8(ap + r * astep + 32 * (ks + u));
#pragma unroll
            for (int c = 0; c < CT; ++c) b[u][c] = ld8(bp + c * bstep + 32 * (ks + u)); }
#pragma unroll
        for (int u = 0; u < 2; ++u)
#pragma unroll
            for (int r = 0; r < RT; ++r)
#pragma unroll
                for (int c = 0; c < CT; ++c) acc[r][c] = SWAP ? mfma16(a[u][r], b[u][c], acc[r][c]) : mfma16(b[u][c], a[u][r], acc[r][c]);
        ks += 2;
    }
    for (; ks < ks1; ++ks) {
        bf16x8 a[RT], b[CT];
#pragma unroll
        for (int r = 0; r < RT; ++r) a[r] = ld8(ap + r * astep + 32 * ks);
#pragma unroll
        for (int c = 0; c < CT; ++c) b[c] = ld8(bp + c * bstep + 32 * ks);
#pragma unroll
        for (int r = 0; r < RT; ++r)
#pragma unroll
            for (int c = 0; c < CT; ++c) acc[r][c] = SWAP ? mfma16(a[r], b[c], acc[r][c]) : mfma16(b[c], a[r], acc[r][c]);
    }
}
template <int NTILE, class F>
__device__ __forceinline__ void sk_reduce(unsigned char* smem, const f32x4* acc, F&& epi) {
    f32x4* red = (f32x4*)smem; const int tid = otid(), w = tid >> 6, lane = tid & 63;
#pragma unroll
    for (int t = 0; t < NTILE; ++t) red[(w * NTILE + t) * 64 + lane] = acc[t];
    __syncthreads();
#pragma unroll
    for (int i = 0; i < (NTILE * 64 + 511) / 512; ++i) { const int s = tid + 512 * i;
        if (s < NTILE * 64) { f32x4 v = red[s];
#pragma unroll
            for (int wv = 1; wv < 8; ++wv) v = v + red[wv * NTILE * 64 + s];
            epi(i, s >> 6, s & 63, v); } }
    __syncthreads();
}
template <int RT, int CT> __device__ __forceinline__ void sk_zero(f32x4 (&acc)[RT][CT]) {
#pragma unroll
    for (int r = 0; r < RT; ++r)
#pragma unroll
        for (int c = 0; c < CT; ++c) acc[r][c] = (f32x4){0.f, 0.f, 0.f, 0.f};
}

__device__ __forceinline__ void phase_convert(const Params& p, unsigned char* smem) {
    float* T = (float*)smem;
    const int tid = otid(), G = gridDim.x;
    unsigned char* ws = p.ws;
    f32x4 pre[8];
    auto issue = [&](int tile, const float*& src, bf16_t*& dst, int& K, int& k0, int& n0) {
        src = p.in[8]; dst = (bf16_t*)(ws + O_WIN); int src_ld = WIN_LD, c0 = 0, ntn = 48, tb = 0; K = D;
#define TDSEL(TB, SRC, DST, LD, C0, KK, NN) if (tile >= (TB)) { src = (SRC); dst = (bf16_t*)(DST); src_ld = (LD); c0 = (C0); K = (KK); ntn = (NN) / 128; tb = (TB); }
        TDSEL(TB1, p.in[8], ws + O_WIN + (size_t)6144 * D * 2, WIN_LD, 6160, D, 10240)
        TDSEL(TB2, p.in[12], ws + O_WGO, D, 0, D, D)
        TDSEL(TB3, p.in[14], ws + O_WCO, D, 0, 1024, D)
        TDSEL(TB4, p.in[15], ws + O_WMKV, 1024, 0, D, 1024)
        TDSEL(TB5, p.in[16], ws + O_WMKV + (size_t)1024 * D * 2, 1024, 0, D, 1024)
        TDSEL(TB6, p.in[17], ws + O_WMO, D, 0, 1024, D)
        TDSEL(TB7, p.in[18], ws + O_WO, D, 0, D, D)
        TDSEL(TB8, p.in[21], ws + O_WGU, DFF, 0, D, DFF)
        TDSEL(TB9, p.in[22], ws + O_WGU + (size_t)DFF * D * 2, DFF, 0, D, DFF)
        TDSEL(TB10, p.in[25], ws + O_WD, D, 0, DFF, D)
#undef TDSEL
        const int lt = tile - tb, kt = lt / ntn, nt = lt - kt * ntn; k0 = kt * 128; n0 = nt * 128;
#pragma unroll
        for (int i = 0; i < 8; ++i) { const int f = tid + 512 * i, kk = f >> 5, n4 = f & 31;
            pre[i] = __builtin_nontemporal_load((const f32x4*)(src + (size_t)(k0 + kk) * src_ld + c0 + n0 + 4 * n4)); }
    };
    const float* src; bf16_t* dst; int K, k0, n0;
    auto tmap = [](int idx) { return idx + TB2 < NTILES ? idx + TB2 : idx + TB2 - NTILES; };
    if ((int)blockIdx.x < NTILES) issue(tmap(blockIdx.x), src, dst, K, k0, n0);
    for (int tile = blockIdx.x; tile < NTILES; tile += G) {
#pragma unroll
        for (int i = 0; i < 8; ++i) { const int f = tid + 512 * i, kk = f >> 5, n4 = f & 31; float* tp = T + kk * 133 + 4 * n4;
            tp[0] = pre[i][0]; tp[1] = pre[i][1]; tp[2] = pre[i][2]; tp[3] = pre[i][3]; }
        bf16_t* cdst = dst; const int cK = K, ck0 = k0, cn0 = n0;
        __syncthreads();
        if (tile + G < NTILES) issue(tmap(tile + G), src, dst, K, k0, n0);
#pragma unroll
        for (int i = 0; i < 4; ++i) { const int it = tid + 512 * i, kg = it & 15, n = it >> 4;
            float f[8];
#pragma unroll
            for (int e = 0; e < 8; ++e) f[e] = T[(8 * kg + e) * 133 + n];
            *(u32x4*)(cdst + (size_t)(cn0 + n) * cK + ck0 + 8 * kg) = pack8(f); }
        __syncthreads();
    }
    bf16_t* Xb = (bf16_t*)(ws + O_XB); bf16_t* Memb = (bf16_t*)(ws + O_MEMB); bf16_t* X1b = (bf16_t*)(ws + O_X1B); bf16_t* Walr = (bf16_t*)(ws + O_WALR);
    const size_t stride = (size_t)G * 512, t0 = (size_t)blockIdx.x * 512 + tid;
    for (size_t it = t0; it < (size_t)NRP * 256; it += stride) { const int row = (int)(it >> 8), c8 = (int)(it & 255) * 8;
        u32x4 w = {0u, 0u, 0u, 0u};
        if (row < NR) { const float* s = row < NP ? p.in[0] + (size_t)row * D + c8 : p.in[1] + (size_t)(row - NP) * D + c8;
            const f32x4 a = __builtin_nontemporal_load((const f32x4*)s), b = __builtin_nontemporal_load((const f32x4*)(s + 4));
            w.x = pk2(a[0], a[1]); w.y = pk2(a[2], a[3]); w.z = pk2(b[0], b[1]); w.w = pk2(b[2], b[3]); }
        else { *(u32x4*)(X1b + (size_t)row * D + c8) = w; }
        *(u32x4*)(Xb + (size_t)row * D + c8) = w; }
    for (size_t it = t0; it < (size_t)1024 * 256; it += stride) { const float* s = p.in[2] + it * 8;
        const f32x4 a = *(const f32x4*)s, b = *(const f32x4*)(s + 4); u32x4 w;
        w.x = pk2(a[0], a[1]); w.y = pk2(a[2], a[3]); w.z = pk2(b[0], b[1]); w.w = pk2(b[2], b[3]);
        *(u32x4*)(Memb + it * 8) = w; }
    for (size_t it = t0; it < (size_t)16 * D; it += stride) { const int r = (int)(it >> 11), k = (int)(it & 2047);
        const float v = p.in[8][(size_t)k * WIN_LD + 6144 + r]; Walr[it] = (bf16_t)(pk2(v, 0.f) & 0xffffu); }
}

__device__ __forceinline__ void p1_sample_inproj(const Params& p, unsigned char* smem, int j) {
    const int tid = otid(), w = tid >> 6, lane = tid & 63, fr = lane & 15, fq = lane >> 4;
    const bf16_t* Xb = (const bf16_t*)(p.ws + O_XB); const bf16_t* Win = (const bf16_t*)(p.ws + O_WIN); bf16_t* P = (bf16_t*)(p.ws + O_P);
    const int col0 = 64 * (j >> 1), row0 = NP + 64 * (j & 1);
    f32x4 acc[4][4]; sk_zero(acc);
    sk_mma<4, 4, false, 2>(acc, Xb + (size_t)(row0 + fr) * D + 8 * fq, (size_t)16 * D, Win + (size_t)(col0 + fr) * D + 8 * fq, (size_t)16 * D, 8 * w, 8 * w + 8);
    const int mode = inproj_mode(col0);
    sk_reduce<16>(smem, &acc[0][0], [&](int, int t, int ln, f32x4 v) { const int rt = t >> 2, ct = t & 3, r = ln & 15, q = ln >> 4;
        v = inproj_act(v, mode); u32x2 o; o.x = pk2(v[0], v[1]); o.y = pk2(v[2], v[3]);
        *(u32x2*)(P + (size_t)(row0 + 16 * rt + r) * LDP + col0 + 16 * ct + 4 * q) = o; });
}
__device__ __forceinline__ void p1_memkv(const Params& p, unsigned char* smem, int j) {
    const int tid = otid(), w = tid >> 6, lane = tid & 63, fr = lane & 15, fq = lane >> 4;
    const bf16_t* Memb = (const bf16_t*)(p.ws + O_MEMB); const bf16_t* Wm = (const bf16_t*)(p.ws + O_WMKV);
    bf16_t* MKb = (bf16_t*)(p.ws + O_MKB); bf16_t* MVT = (bf16_t*)(p.ws + O_MVT);
    const int rb = j >> 5, cb = j & 31, col0 = 64 * cb, arow0 = 64 * rb;
    f32x4 acc[4][4]; sk_zero(acc);
    const bf16_t* ap = Memb + (size_t)(arow0 + fr) * D + 8 * fq; const bf16_t* bp = Wm + (size_t)(col0 + fr) * D + 8 * fq;
    float* out = p.out;
    if (col0 < 1024) {
        sk_mma<4, 4, false, 2>(acc, ap, (size_t)16 * D, bp, (size_t)16 * D, 8 * w, 8 * w + 8);
        sk_reduce<16>(smem, &acc[0][0], [&](int, int t, int ln, f32x4 v) { const int rt = t >> 2, ct = t & 3, r = ln & 15, q = ln >> 4;
            const int row = arow0 + 16 * rt + r, col = col0 + 16 * ct + 4 * q;
            *(f32x4*)(out + OUT_PMK + (size_t)row * 1024 + col) = v;
            u32x2 o; o.x = pk2(v[0], v[1]); o.y = pk2(v[2], v[3]); *(u32x2*)(MKb + (size_t)row * 1024 + col) = o; });
    } else {
        sk_mma<4, 4, true, 2>(acc, ap, (size_t)16 * D, bp, (size_t)16 * D, 8 * w, 8 * w + 8);
        sk_reduce<16>(smem, &acc[0][0], [&](int, int t, int ln, f32x4 v) { const int rt = t >> 2, ct = t & 3, r = ln & 15, q = ln >> 4;
            const int row = arow0 + 16 * rt + 4 * q, c = col0 - 1024 + 16 * ct + r, b = row >> 8, mloc = row & 255;
#pragma unroll
            for (int e = 0; e < 4; ++e) out[OUT_PMV + (size_t)(row + e) * 1024 + c] = v[e];
            u32x2 o; o.x = pk2(v[0], v[1]); o.y = pk2(v[2], v[3]); *(u32x2*)(MVT + ((size_t)b * 1024 + c) * 256 + mloc) = o; });
    }
}
__device__ __forceinline__ void p1_alr(const Params& p, unsigned char* smem, int j2) {
    const int tid = otid(), w = tid >> 6, lane = tid & 63, fr = lane & 15, fq = lane >> 4;
    const int j = j2 >> 1, half = j2 & 1;
    const bf16_t* Xb = (const bf16_t*)(p.ws + O_XB); const bf16_t* Walr = (const bf16_t*)(p.ws + O_WALR); float* BC = (float*)(p.ws + O_BC);
    float* alr = (float*)(smem + 32768);
    const int k = half * 512 + tid;
    float w2[16];
#pragma unroll
    for (int r = 0; r < 16; ++r) w2[r] = p.in[9][r * 1024 + k];
    const float bb = p.in[10][k];
    { f32x4 acc[4][1]; sk_zero(acc);
      sk_mma<4, 1, false, 4>(acc, Xb + (size_t)(64 * j + fr) * D + 8 * fq, (size_t)16 * D, Walr + (size_t)fr * D + 8 * fq, 0, 8 * w, 8 * w + 8);
      sk_reduce<4>(smem, &acc[0][0], [&](int, int t, int ln, f32x4 v) { *(f32x4*)(alr + (16 * t + (ln & 15)) * 16 + 4 * (ln >> 4)) = v; }); }
    const bool prompt = (64 * j) < NP;
    float run = 0.f;
    float* bcp = BC + (size_t)(64 * j) * 1024 + k;
#pragma unroll 4
    for (int t = 0; t < 64; ++t) { float z = bb;
#pragma unroll
        for (int r4 = 0; r4 < 4; ++r4) { const f32x4 a = *(const f32x4*)(alr + t * 16 + 4 * r4); z += a[0] * w2[4 * r4] + a[1] * w2[4 * r4 + 1] + a[2] * w2[4 * r4 + 2] + a[3] * w2[4 * r4 + 3]; }
        const float la = (fminf(z, 0.f) - __logf(1.0f + __expf(-fabsf(z)))) * 0.0625f;
        run = prompt ? run + la : la;
        bcp[(size_t)t * 1024] = run; }
    __syncthreads();
}

constexpr int QS = 264, TS = 72;
__device__ __forceinline__ void gla_prompt_job(const Params& p, unsigned char* smem, int g) {
    const int tid = otid(), w = tid >> 6, lane = tid & 63, fr = lane & 15, fq = lane >> 4;
    const int b = g >> 5, h = (g >> 3) & 3, j = g & 7;
    const bf16_t* P = (const bf16_t*)(p.ws + O_P); const float* BC = (const float*)(p.ws + O_BC); bf16_t* OG = (bf16_t*)(p.ws + O_OG);
    bf16_t* Qt = (bf16_t*)smem; bf16_t* Kt = Qt + 64 * QS; bf16_t* ST = Kt + 64 * QS; bf16_t* KtT = ST + 64 * QS; bf16_t* VT = KtT + 256 * TS; bf16_t* Pm = VT + 64 * TS;
    float* Dk = (float*)(Pm + 64 * TS);
    for (int i = tid; i < 64 * QS / 8; i += 512) ((u32x4*)ST)[i] = (u32x4){0u, 0u, 0u, 0u};
    f32x4 sacc[2][4];
#pragma unroll
    for (int a = 0; a < 2; ++a)
#pragma unroll
        for (int c = 0; c < 4; ++c) sacc[a][c] = (f32x4){0.f, 0.f, 0.f, 0.f};
    const size_t R0 = (size_t)b * 2048;
    u32x4 pq[4], pk[4], pv; f32x4 pb0[4], pb1[4]; float pd = 0.f;
#define GLA_PREFETCH(RB) do { const size_t rb_ = (RB); \
        _Pragma("unroll") for (int i = 0; i < 4; ++i) { const int s = tid + 512 * i, t = s >> 5, ks = s & 31; \
            const bf16_t* prow = P + (rb_ + t) * LDP + h * 256 + 8 * ks; pq[i] = *(const u32x4*)(prow + Q_OFF); pk[i] = *(const u32x4*)(prow + K_OFF); \
            const float* bcp = BC + (rb_ + t) * 1024 + h * 256 + 8 * ks; pb0[i] = *(const f32x4*)bcp; pb1[i] = *(const f32x4*)(bcp + 4); } \
        pv = *(const u32x4*)(P + (rb_ + (tid >> 3)) * LDP + V_OFF + h * 512 + j * 64 + 8 * (tid & 7)); \
        if (tid < 256) pd = BC[(rb_ + 63) * 1024 + h * 256 + tid]; } while (0)
    GLA_PREFETCH(R0);
    for (int n = 0; n < 32; ++n) {
        const size_t r0 = R0 + 64 * n;
#pragma unroll
        for (int i = 0; i < 4; ++i) { const int s = tid + 512 * i, t = s >> 5, ks = s & 31;
            float qf[8], kf[8]; unpack8(pq[i], qf); unpack8(pk[i], kf);
#pragma unroll
            for (int e = 0; e < 8; ++e) { const float bc = e < 4 ? pb0[i][e & 3] : pb1[i][e & 3]; qf[e] *= __expf(bc); kf[e] *= __expf(-bc); }
            *(u32x4*)(Qt + t * QS + 8 * ks) = pack8(qf); *(u32x4*)(Kt + t * QS + 8 * ks) = pack8(kf); }
        { const int t = tid >> 3, vs = tid & 7; const u32x4 v8 = pv;
            bf16_t* vp = VT + (8 * vs) * TS + t;
            vp[0 * TS] = (bf16_t)(v8.x & 0xffffu); vp[1 * TS] = (bf16_t)(v8.x >> 16); vp[2 * TS] = (bf16_t)(v8.y & 0xffffu); vp[3 * TS] = (bf16_t)(v8.y >> 16);
            vp[4 * TS] = (bf16_t)(v8.z & 0xffffu); vp[5 * TS] = (bf16_t)(v8.z >> 16); vp[6 * TS] = (bf16_t)(v8.w & 0xffffu); vp[7 * TS] = (bf16_t)(v8.w >> 16); }
        if (tid < 256) Dk[tid] = __expf(pd);
        if (n + 1 < 32) GLA_PREFETCH(r0 + 64);
        __syncthreads();
#pragma unroll
        for (int i = 0; i < 4; ++i) { const int s = tid + 512 * i, t = s & 63, ks = s >> 6;
            const u32x4 k8 = *(const u32x4*)(Kt + t * QS + 8 * ks);
            bf16_t* kp = KtT + (8 * ks) * TS + t;
            kp[0 * TS] = (bf16_t)(k8.x & 0xffffu); kp[1 * TS] = (bf16_t)(k8.x >> 16); kp[2 * TS] = (bf16_t)(k8.y & 0xffffu); kp[3 * TS] = (bf16_t)(k8.y >> 16);
            kp[4 * TS] = (bf16_t)(k8.z & 0xffffu); kp[5 * TS] = (bf16_t)(k8.z >> 16); kp[6 * TS] = (bf16_t)(k8.w & 0xffffu); kp[7 * TS] = (bf16_t)(k8.w >> 16); }
#pragma unroll
        for (int i = 0; i < 2; ++i) { const int T = 2 * w + i, tt = T >> 2, st = T & 3;
            f32x4 a = (f32x4){0.f, 0.f, 0.f, 0.f};
            if (st <= tt) {
#pragma unroll
                for (int ks = 0; ks < 8; ++ks) a = mfma16(ld8(Kt + (16 * st + fr) * QS + 32 * ks + 8 * fq), ld8(Qt + (16 * tt + fr) * QS + 32 * ks + 8 * fq), a); }
            const int tl = 16 * tt + fr, sl = 16 * st + 4 * fq;
#pragma unroll
            for (int r = 0; r < 4; ++r) if (sl + r > tl) a[r] = 0.f;
            u32x2 o; o.x = pk2(a[0], a[1]); o.y = pk2(a[2], a[3]); *(u32x2*)(Pm + tl * TS + sl) = o; }
        __syncthreads();
#pragma unroll
        for (int i = 0; i < 2; ++i) { const int T = 2 * w + i, tt = T >> 2, vt = T & 3;
            f32x4 a = (f32x4){0.f, 0.f, 0.f, 0.f};
#pragma unroll
            for (int ks = 0; ks < 2; ++ks) a = mfma16(ld8(VT + (16 * vt + fr) * TS + 32 * ks + 8 * fq), ld8(Pm + (16 * tt + fr) * TS + 32 * ks + 8 * fq), a);
#pragma unroll
            for (int ks = 0; ks < 8; ++ks) a = mfma16(ld8(ST + (16 * vt + fr) * QS + 32 * ks + 8 * fq), ld8(Qt + (16 * tt + fr) * QS + 32 * ks + 8 * fq), a);
            u32x2 ow; ow.x = pk2(a[0], a[1]); ow.y = pk2(a[2], a[3]); *(u32x2*)(OG + (r0 + 16 * tt + fr) * D + h * 512 + j * 64 + 16 * vt + 4 * fq) = ow; }
        __syncthreads();
#pragma unroll
        for (int k2 = 0; k2 < 2; ++k2) { const int kt = 2 * w + k2;
            const bf16x8 X0 = ld8(KtT + (16 * kt + fr) * TS + 8 * fq), X1 = ld8(KtT + (16 * kt + fr) * TS + 32 + 8 * fq);
            const f32x4 dk = *(const f32x4*)(Dk + 16 * kt + 4 * fq);
#pragma unroll
            for (int vt = 0; vt < 4; ++vt) { f32x4 a = sacc[k2][vt];
                a = mfma16(X0, ld8(VT + (16 * vt + fr) * TS + 8 * fq), a); a = mfma16(X1, ld8(VT + (16 * vt + fr) * TS + 32 + 8 * fq), a);
                a = a * dk; sacc[k2][vt] = a;
                u32x2 o; o.x = pk2(a[0], a[1]); o.y = pk2(a[2], a[3]); *(u32x2*)(ST + (16 * vt + fr) * QS + 16 * kt + 4 * fq) = o; } }
        __syncthreads();
    }
#undef GLA_PREFETCH
    float* so = p.out + OUT_PGLA + ((size_t)(b * 4 + h) * 256) * 512 + j * 64;
#pragma unroll
    for (int k2 = 0; k2 < 2; ++k2)
#pragma unroll
        for (int vt = 0; vt < 4; ++vt)
#pragma unroll
            for (int r = 0; r < 4; ++r) so[(size_t)(16 * (2 * w + k2) + 4 * fq + r) * 512 + 16 * vt + fr] = sacc[k2][vt][r];
}

__device__ __forceinline__ void gla_sample_job(const Params& p, unsigned char* smem, int jb) {
    const int tid = otid(); const int b = jb >> 2, h = jb & 3;
    const bf16_t* P = (const bf16_t*)(p.ws + O_P); const float* BC = (const float*)(p.ws + O_BC); bf16_t* OG = (bf16_t*)(p.ws + O_OG);
    float* sq = (float*)smem; float* sk = sq + 256; float* sa = sk + 256; float* red = sa + 256;
    const size_t row = (size_t)NP + b;
    if (tid < 256) { const bf16_t* prow = P + row * LDP + h * 256 + tid; sq[tid] = bf2f(prow[Q_OFF]); sk[tid] = bf2f(prow[K_OFF]); sa[tid] = __expf(BC[row * 1024 + h * 256 + tid]); }
    const int v4 = tid & 127, kg = tid >> 7;
    const u32x2 vv = *(const u32x2*)(P + row * LDP + V_OFF + h * 512 + 4 * v4);
    f32x4 v; v[0] = bflo(vv.x); v[1] = bfhi(vv.x); v[2] = bflo(vv.y); v[3] = bfhi(vv.y);
    const f32x4* Sin = (const f32x4*)(p.in[5] + ((size_t)(b * 4 + h) * 256 + kg * 64) * 512) + v4;
    f32x4* Sout = (f32x4*)(p.out + OUT_SGLA + ((size_t)(b * 4 + h) * 256 + kg * 64) * 512) + v4;
    f32x4 s0[16];
#pragma unroll
    for (int i = 0; i < 16; ++i) s0[i] = __builtin_nontemporal_load(Sin + (size_t)i * 128);
    __syncthreads();
    f32x4 o = (f32x4){0.f, 0.f, 0.f, 0.f};
    for (int k0 = 0; k0 < 64; k0 += 16) {
        f32x4 s[16];
#pragma unroll
        for (int i = 0; i < 16; ++i) s[i] = s0[i];
        if (k0 + 16 < 64) {
#pragma unroll
            for (int i = 0; i < 16; ++i) s0[i] = __builtin_nontemporal_load(Sin + (size_t)(k0 + 16 + i) * 128); }
#pragma unroll
        for (int i = 0; i < 16; ++i) { const int k = kg * 64 + k0 + i;
            s[i] = s[i] * sa[k] + v * sk[k];
            __builtin_nontemporal_store(s[i], Sout + (size_t)(k0 + i) * 128);
            o = o + s[i] * sq[k]; }
    }
    *(f32x4*)(red + kg * 512 + 4 * v4) = o;
    __syncthreads();
    if (tid < 128) { const f32x4 r = *(const f32x4*)(red + 4 * tid) + *(const f32x4*)(red + 512 + 4 * tid) + *(const f32x4*)(red + 1024 + 4 * tid) + *(const f32x4*)(red + 1536 + 4 * tid);
        u32x2 ow; ow.x = pk2(r[0], r[1]); ow.y = pk2(r[2], r[3]); *(u32x2*)(OG + row * D + h * 512 + 4 * tid) = ow; }
    __syncthreads();
}

__device__ __forceinline__ void attn_prompt_job(const Params& p, int j) {
    const int tid = otid(), w = tid >> 6, lane = tid & 63, fr = lane & 15, fq = lane >> 4;
    const int b = j >> 6, h = (j >> 4) & 3, qt = j & 15;
    const bf16_t* P = (const bf16_t*)(p.ws + O_P); const bf16_t* MKb = (const bf16_t*)(p.ws + O_MKB); const bf16_t* MVT = (const bf16_t*)(p.ws + O_MVT); bf16_t* Am = (bf16_t*)(p.ws + O_AM);
    const size_t row = (size_t)b * 2048 + qt * 128 + 16 * w + fr;
    const bf16_t* qp = P + row * LDP + MQ_OFF + h * 256 + 8 * fq;
    bf16x8 Yq[8];
#pragma unroll
    for (int ks = 0; ks < 8; ++ks) Yq[ks] = ld8(qp + 32 * ks);
    f32x4 lg[16];
    const bf16_t* kp = MKb + (size_t)(b * 256 + fr) * 1024 + h * 256 + 8 * fq;
#pragma unroll
    for (int m2 = 0; m2 < 8; ++m2) {
        bf16x8 kf[2][8];
#pragma unroll
        for (int t = 0; t < 2; ++t)
#pragma unroll
            for (int ks = 0; ks < 8; ++ks) kf[t][ks] = ld8(kp + (size_t)(2 * m2 + t) * 16 * 1024 + 32 * ks);
#pragma unroll
        for (int t = 0; t < 2; ++t) { f32x4 a = (f32x4){0.f, 0.f, 0.f, 0.f};
#pragma unroll
            for (int ks = 0; ks < 8; ++ks) a = mfma16(kf[t][ks], Yq[ks], a);
            lg[2 * m2 + t] = a; } }
    float mx = -3.0e38f;
#pragma unroll
    for (int mt = 0; mt < 16; ++mt) mx = fmaxf(fmaxf(fmaxf(lg[mt][0], lg[mt][1]), fmaxf(lg[mt][2], lg[mt][3])), mx);
    mx = fmaxf(mx, __shfl_xor(mx, 16)); mx = fmaxf(mx, __shfl_xor(mx, 32));
    float sum = 0.f;
    bf16x8 Yp[8];
#pragma unroll
    for (int i = 0; i < 8; ++i) { u32x4 wv; f32x4 e0, e1;
#pragma unroll
        for (int r = 0; r < 4; ++r) { e0[r] = __expf(lg[2 * i][r] - mx); e1[r] = __expf(lg[2 * i + 1][r] - mx); }
        sum += (e0[0] + e0[1]) + (e0[2] + e0[3]) + (e1[0] + e1[1]) + (e1[2] + e1[3]);
        wv.x = pk2(e0[0], e0[1]); wv.y = pk2(e0[2], e0[3]); wv.z = pk2(e1[0], e1[1]); wv.w = pk2(e1[2], e1[3]);
        Yp[i] = __builtin_bit_cast(bf16x8, wv); }
    sum += __shfl_xor(sum, 16); sum += __shfl_xor(sum, 32);
    const float inv = 1.0f / sum;
    const bf16_t* vp = MVT + ((size_t)b * 1024 + h * 256 + fr) * 256 + 4 * fq;
    bf16_t* op = Am + row * 1024 + h * 256 + 4 * fq;
    u32x2 vf[2][2][8][2];
#pragma unroll
    for (int t = 0; t < 2; ++t)
#pragma unroll
        for (int i = 0; i < 8; ++i) { vf[0][t][i][0] = *(const u32x2*)(vp + (size_t)t * 16 * 256 + 32 * i); vf[0][t][i][1] = *(const u32x2*)(vp + (size_t)t * 16 * 256 + 32 * i + 16); }
#pragma unroll
    for (int d2 = 0; d2 < 8; ++d2) {
        if (d2 + 1 < 8) {
#pragma unroll
            for (int t = 0; t < 2; ++t)
#pragma unroll
                for (int i = 0; i < 8; ++i) { const bf16_t* q = vp + (size_t)(2 * (d2 + 1) + t) * 16 * 256 + 32 * i;
                    vf[(d2 + 1) & 1][t][i][0] = *(const u32x2*)q; vf[(d2 + 1) & 1][t][i][1] = *(const u32x2*)(q + 16); } }
#pragma unroll
        for (int t = 0; t < 2; ++t) { f32x4 a = (f32x4){0.f, 0.f, 0.f, 0.f};
#pragma unroll
            for (int i = 0; i < 8; ++i) { u32x4 xv; xv.x = vf[d2 & 1][t][i][0].x; xv.y = vf[d2 & 1][t][i][0].y; xv.z = vf[d2 & 1][t][i][1].x; xv.w = vf[d2 & 1][t][i][1].y;
                a = mfma16(__builtin_bit_cast(bf16x8, xv), Yp[i], a); }
            a = a * inv; u32x2 o; o.x = pk2(a[0], a[1]); o.y = pk2(a[2], a[3]); *(u32x2*)(op + 16 * (2 * d2 + t)) = o; } }
}

__device__ __forceinline__ void attn_sample_job(const Params& p, unsigned char* smem, int b) {
    const int tid = otid(), w = tid >> 6, lane = tid & 63;
    const bf16_t* P = (const bf16_t*)(p.ws + O_P); bf16_t* Am = (bf16_t*)(p.ws + O_AM);
    float* sq = (float*)smem; float* lg = sq + 1024; f32x4* red = (f32x4*)(smem + 8192);
    for (int i = tid; i < 1024; i += 512) sq[i] = bf2f(P[(size_t)(NP + b) * LDP + MQ_OFF + i]);
    const f32x4* kc = (const f32x4*)(p.in[3] + (size_t)b * 256 * 1024) + (size_t)w * 128 * 64 + lane;
    f32x4 k0[8];
#pragma unroll
    for (int i = 0; i < 8; ++i) k0[i] = __builtin_nontemporal_load(kc + (size_t)i * 64);
    __syncthreads();
    for (int r0 = 0; r0 < 128; r0 += 8) {
        f32x4 kv[8];
#pragma unroll
        for (int i = 0; i < 8; ++i) kv[i] = k0[i];
        if (r0 + 8 < 128) {
#pragma unroll
            for (int i = 0; i < 8; ++i) k0[i] = __builtin_nontemporal_load(kc + (size_t)(r0 + 8 + i) * 64); }
#pragma unroll
        for (int i = 0; i < 8; ++i) { const int rho = w * 128 + r0 + i, hh = rho & 3;
            const f32x4 qv = *(const f32x4*)(sq + hh * 256 + 4 * lane);
            float d = kv[i][0] * qv[0] + kv[i][1] * qv[1] + kv[i][2] * qv[2] + kv[i][3] * qv[3];
            d = wave_sum(d);
            if (lane == 0) lg[hh * 256 + (rho >> 2)] = d; }
    }
    __syncthreads();
    if (w < 4) { float l[4]; float mx = -3.0e38f;
#pragma unroll
        for (int i = 0; i < 4; ++i) { l[i] = lg[w * 256 + lane + 64 * i]; mx = fmaxf(mx, l[i]); }
        for (int o = 32; o >= 1; o >>= 1) mx = fmaxf(mx, __shfl_xor(mx, o));
        float sm = 0.f;
#pragma unroll
        for (int i = 0; i < 4; ++i) { l[i] = __expf(l[i] - mx); sm += l[i]; }
        sm = wave_sum(sm); const float inv = 1.0f / sm;
#pragma unroll
        for (int i = 0; i < 4; ++i) lg[w * 256 + lane + 64 * i] = l[i] * inv; }
    const int c4 = tid & 255, mh = tid >> 8, hh = c4 >> 6;
    const f32x4* vc = (const f32x4*)(p.in[4] + (size_t)b * 256 * 1024) + (size_t)mh * 128 * 256 + c4;
    f32x4 v0[16];
#pragma unroll
    for (int i = 0; i < 16; ++i) v0[i] = __builtin_nontemporal_load(vc + (size_t)i * 256);
    __syncthreads();
    f32x4 a = (f32x4){0.f, 0.f, 0.f, 0.f};
    for (int m0 = 0; m0 < 128; m0 += 16) {
        f32x4 vv[16];
#pragma unroll
        for (int i = 0; i < 16; ++i) vv[i] = v0[i];
        if (m0 + 16 < 128) {
#pragma unroll
            for (int i = 0; i < 16; ++i) v0[i] = __builtin_nontemporal_load(vc + (size_t)(m0 + 16 + i) * 256); }
#pragma unroll
        for (int i = 0; i < 16; ++i) a = a + vv[i] * lg[hh * 256 + mh * 128 + m0 + i];
    }
    red[mh * 256 + c4] = a;
    __syncthreads();
    if (tid < 256) { const f32x4 r = red[tid] + red[256 + tid]; u32x2 o; o.x = pk2(r[0], r[1]); o.y = pk2(r[2], r[3]);
        *(u32x2*)(Am + (size_t)(NP + b) * 1024 + 4 * tid) = o; }
    __syncthreads();
}

__device__ __forceinline__ void conv_job(const Params& p, int jc) {
    const int tid = otid(), seg = tid & 127, run = tid >> 7, c = 8 * seg;
    const bf16_t* P = (const bf16_t*)(p.ws + O_P); bf16_t* Ab = (bf16_t*)(p.ws + O_AB);
    const float* wc = p.in[13];
    float w0[8], w1[8], w2[8];
    { const f32x4 a0 = *(const f32x4*)(wc + c), a1 = *(const f32x4*)(wc + c + 4), b0 = *(const f32x4*)(wc + 1024 + c), b1 = *(const f32x4*)(wc + 1024 + c + 4), c0 = *(const f32x4*)(wc + 2048 + c), c1 = *(const f32x4*)(wc + 2048 + c + 4);
#pragma unroll
      for (int e = 0; e < 4; ++e) { w0[e] = a0[e]; w0[4 + e] = a1[e]; w1[e] = b0[e]; w1[4 + e] = b1[e]; w2[e] = c0[e]; w2[4 + e] = c1[e]; } }
    const int rowb = 128 * jc + 32 * run;
    const bf16_t* pb = P + (size_t)rowb * LDP + c;
    if (rowb < NP) {
        const int t0 = rowb & 2047, b = rowb >> 11;
        float u0[8], u1[8];
#pragma unroll
        for (int e = 0; e < 8; ++e) { u0[e] = 0.f; u1[e] = 0.f; }
        if (t0 >= 2) { float a[8], bq[8];
            unpack8(*(const u32x4*)(pb - 2 * LDP + CC_OFF), a); unpack8(*(const u32x4*)(pb - 2 * LDP + CH_OFF), bq);
#pragma unroll
            for (int e = 0; e < 8; ++e) u0[e] = a[e] * bq[e];
            unpack8(*(const u32x4*)(pb - LDP + CC_OFF), a); unpack8(*(const u32x4*)(pb - LDP + CH_OFF), bq);
#pragma unroll
            for (int e = 0; e < 8; ++e) u1[e] = a[e] * bq[e]; }
        for (int r0 = 0; r0 < 32; r0 += 4) {
            u32x4 xc[4], xh[4], xb[4];
#pragma unroll
            for (int i = 0; i < 4; ++i) { const bf16_t* pr = pb + (size_t)(r0 + i) * LDP; xc[i] = *(const u32x4*)(pr + CC_OFF); xh[i] = *(const u32x4*)(pr + CH_OFF); xb[i] = *(const u32x4*)(pr + CB_OFF); }
#pragma unroll
            for (int i = 0; i < 4; ++i) { float a[8], bq[8], cb[8], u2[8], y[8];
                unpack8(xc[i], a); unpack8(xh[i], bq); unpack8(xb[i], cb);
#pragma unroll
                for (int e = 0; e < 8; ++e) { u2[e] = a[e] * bq[e]; y[e] = cb[e] * (w0[e] * u0[e] + w1[e] * u1[e] + w2[e] * u2[e]); u0[e] = u1[e]; u1[e] = u2[e]; }
                *(u32x4*)(Ab + (size_t)(rowb + r0 + i) * 1024 + c) = pack8(y);
                const int t = t0 + r0 + i;
                if (t >= 2046) { float* so = p.out + OUT_PCONV + (size_t)(b * 2 + (t - 2046)) * 1024 + c;
#pragma unroll
                    for (int e = 0; e < 8; ++e) so[e] = u2[e]; } }
        }
    } else {
        for (int r0 = 0; r0 < 32; r0 += 4) {
            u32x4 xc[4], xh[4], xb[4]; f32x4 st[4][4];
#pragma unroll
            for (int i = 0; i < 4; ++i) { const bf16_t* pr = pb + (size_t)(r0 + i) * LDP; xc[i] = *(const u32x4*)(pr + CC_OFF); xh[i] = *(const u32x4*)(pr + CH_OFF); xb[i] = *(const u32x4*)(pr + CB_OFF);
                const float* sc = p.in[6] + (size_t)(rowb - NP + r0 + i) * 2048 + c;
                st[i][0] = *(const f32x4*)sc; st[i][1] = *(const f32x4*)(sc + 4); st[i][2] = *(const f32x4*)(sc + 1024); st[i][3] = *(const f32x4*)(sc + 1028); }
#pragma unroll
            for (int i = 0; i < 4; ++i) { float a[8], bq[8], cb[8], y[8]; f32x4 un0, un1;
                unpack8(xc[i], a); unpack8(xh[i], bq); unpack8(xb[i], cb);
#pragma unroll
                for (int e = 0; e < 8; ++e) { const float u0 = e < 4 ? st[i][0][e & 3] : st[i][1][e & 3], u1 = e < 4 ? st[i][2][e & 3] : st[i][3][e & 3], u2 = a[e] * bq[e];
                    y[e] = cb[e] * (w0[e] * u0 + w1[e] * u1 + w2[e] * u2); if (e < 4) un0[e & 3] = u2; else un1[e & 3] = u2; }
                const size_t bs = (size_t)(rowb - NP + r0 + i);
                *(u32x4*)(Ab + (size_t)(rowb + r0 + i) * 1024 + c) = pack8(y);
                float* so = p.out + OUT_SCONV + bs * 2048 + c;
                *(f32x4*)so = st[i][2]; *(f32x4*)(so + 4) = st[i][3]; *(f32x4*)(so + 1024) = un0; *(f32x4*)(so + 1028) = un1; }
        }
    }
}

__device__ __forceinline__ void phase_gla_norm(const Params& p) {
    const int tid = otid(), w = tid >> 6, lane = tid & 63;
    const bf16_t* P = (const bf16_t*)(p.ws + O_P); const bf16_t* OG = (const bf16_t*)(p.ws + O_OG); bf16_t* Aa = (bf16_t*)(p.ws + O_AA);
    const f32x4 g0 = *(const f32x4*)(p.in[11] + 8 * lane), g1 = *(const f32x4*)(p.in[11] + 8 * lane + 4);
    for (int row = blockIdx.x * 8 + w; row < NR; row += gridDim.x * 8) {
        f32x4 a[4], b[4]; u32x4 sgw[4];
#pragma unroll
        for (int h = 0; h < 4; ++h) { const u32x4 ow = __builtin_nontemporal_load((const u32x4*)(OG + (size_t)row * D + h * 512 + 8 * lane));
            a[h][0] = bflo(ow.x); a[h][1] = bfhi(ow.x); a[h][2] = bflo(ow.y); a[h][3] = bfhi(ow.y); b[h][0] = bflo(ow.z); b[h][1] = bfhi(ow.z); b[h][2] = bflo(ow.w); b[h][3] = bfhi(ow.w);
            sgw[h] = *(const u32x4*)(P + (size_t)row * LDP + G_OFF + h * 512 + 8 * lane); }
#pragma unroll
        for (int h = 0; h < 4; ++h) {
            float ss = a[h][0] * a[h][0] + a[h][1] * a[h][1] + a[h][2] * a[h][2] + a[h][3] * a[h][3] + b[h][0] * b[h][0] + b[h][1] * b[h][1] + b[h][2] * b[h][2] + b[h][3] * b[h][3];
            ss = wave_sum(ss); const float rstd = rsqrtf(ss * (1.0f / 512.0f) + 1e-6f);
            float sg[8]; unpack8(sgw[h], sg);
            float y[8];
#pragma unroll
            for (int e = 0; e < 4; ++e) { y[e] = a[h][e] * rstd * g0[e] * sg[e]; y[4 + e] = b[h][e] * rstd * g1[e] * sg[4 + e]; }
            *(u32x4*)(Aa + (size_t)row * D + h * 512 + 8 * lane) = pack8(y); } }
}
template <bool FINAL>
__device__ __forceinline__ void phase_ln(const Params& p, const bf16_t* H, const float* gam, const float* bet) {
    const int tid = otid(), w = tid >> 6, lane = tid & 63;
    bf16_t* X1b = (bf16_t*)(p.ws + O_X1B);
    for (int row = blockIdx.x * 8 + w; row < NR; row += gridDim.x * 8) {
        u32x4 hw[4];
#pragma unroll
        for (int i = 0; i < 4; ++i) hw[i] = __builtin_nontemporal_load((const u32x4*)(H + (size_t)row * D + 8 * (lane + 64 * i)));
        float v[4][8]; float s = 0.f;
#pragma unroll
        for (int i = 0; i < 4; ++i) { unpack8(hw[i], v[i]);
#pragma unroll
            for (int e = 0; e < 8; ++e) s += v[i][e]; }
        const float mu = wave_sum(s) * (1.0f / 2048.0f);
        float q = 0.f;
#pragma unroll
        for (int i = 0; i < 4; ++i)
#pragma unroll
            for (int e = 0; e < 8; ++e) { v[i][e] -= mu; q += v[i][e] * v[i][e]; }
        const float rstd = rsqrtf(wave_sum(q) * (1.0f / 2048.0f) + 1e-5f);
        float* orow = row < NP ? p.out + OUT_YP + (size_t)row * D : p.out + OUT_YS + (size_t)(row - NP) * D;
#pragma unroll
        for (int i = 0; i < 4; ++i) { const int c = 8 * (lane + 64 * i);
            const f32x4 g0 = *(const f32x4*)(gam + c), g1 = *(const f32x4*)(gam + c + 4), b0 = *(const f32x4*)(bet + c), b1 = *(const f32x4*)(bet + c + 4);
            float y[8];
#pragma unroll
            for (int e = 0; e < 4; ++e) { y[e] = v[i][e] * rstd * g0[e] + b0[e]; y[4 + e] = v[i][4 + e] * rstd * g1[e] + b1[e]; }
            if (FINAL) { __builtin_nontemporal_store((f32x4){y[0], y[1], y[2], y[3]}, (f32x4*)(orow + c)); __builtin_nontemporal_store((f32x4){y[4], y[5], y[6], y[7]}, (f32x4*)(orow + c + 4)); }
            else *(u32x4*)(X1b + (size_t)row * D + c) = pack8(y); } }
}
__device__ __forceinline__ void phase_ffn_mid(const Params& p) {
    const bf16_t* HGU = (const bf16_t*)(p.ws + O_P); bf16_t* Af = (bf16_t*)(p.ws + O_OG);
    const float* wf = p.in[23]; const float* bf = p.in[24];
    const size_t stride = (size_t)gridDim.x * 512, t00 = (size_t)blockIdx.x * 512 + otid();
    for (size_t u = t00; u < (size_t)(NP / 16) * 688; u += stride) { const int rb = (int)(u / 688), seg = (int)(u - (size_t)rb * 688), c = 8 * seg, row0 = 16 * rb, t0 = row0 & 2047, b = row0 >> 11;
        float w0[8], w1[8], w2[8], bb[8];
        { const f32x4 a0 = *(const f32x4*)(wf + c), a1 = *(const f32x4*)(wf + c + 4), b0 = *(const f32x4*)(wf + DFF + c), b1 = *(const f32x4*)(wf + DFF + c + 4), c0 = *(const f32x4*)(wf + 2 * DFF + c), c1 = *(const f32x4*)(wf + 2 * DFF + c + 4), d0 = *(const f32x4*)(bf + c), d1 = *(const f32x4*)(bf + c + 4);
#pragma unroll
          for (int e = 0; e < 4; ++e) { w0[e] = a0[e]; w0[4 + e] = a1[e]; w1[e] = b0[e]; w1[4 + e] = b1[e]; w2[e] = c0[e]; w2[4 + e] = c1[e]; bb[e] = d0[e]; bb[4 + e] = d1[e]; } }
        const bf16_t* hb = HGU + (size_t)row0 * NGU + c;
        float h0[8], h1[8];
#pragma unroll
        for (int e = 0; e < 8; ++e) { h0[e] = 0.f; h1[e] = 0.f; }
        if (t0 >= 2) { unpack8(*(const u32x4*)(hb - 2 * NGU), h0); unpack8(*(const u32x4*)(hb - NGU), h1); }
        for (int r0 = 0; r0 < 16; r0 += 8) {
            u32x4 xg[8], xu[8];
#pragma unroll
            for (int i = 0; i < 8; ++i) { const bf16_t* hr = hb + (size_t)(r0 + i) * NGU; xg[i] = __builtin_nontemporal_load((const u32x4*)hr); xu[i] = __builtin_nontemporal_load((const u32x4*)(hr + DFF)); }
#pragma unroll
            for (int i = 0; i < 8; ++i) { float h2[8], hu[8], y[8]; unpack8(xg[i], h2); unpack8(xu[i], hu);
#pragma unroll
                for (int e = 0; e < 8; ++e) { const float hc = w0[e] * h0[e] + w1[e] * h1[e] + w2[e] * h2[e] + bb[e]; y[e] = silu(hc) * hu[e]; h0[e] = h1[e]; h1[e] = h2[e]; }
                *(u32x4*)(Af + (size_t)(row0 + r0 + i) * DFF + c) = pack8(y);
                const int t = t0 + r0 + i;
                if (t >= 2046) { float* so = p.out + OUT_PFFN + (size_t)(b * 2 + (t - 2046)) * DFF + c;
#pragma unroll
                    for (int e = 0; e < 8; ++e) so[e] = h2[e]; } }
        }
    }
    for (size_t it = t00; it < (size_t)NS * 688; it += stride) { const int bs = (int)(it / 688), seg = (int)(it - (size_t)bs * 688), c = 8 * seg;
        const bf16_t* hrow = HGU + (size_t)(NP + bs) * NGU + c;
        float h0[8], h1[8], h2[8], hu[8], y[8];
        unpack8(*(const u32x4*)hrow, h2); unpack8(*(const u32x4*)(hrow + DFF), hu);
        const float* sc = p.in[7] + (size_t)bs * 2 * DFF + c; float* so = p.out + OUT_SFFN + (size_t)bs * 2 * DFF + c;
#pragma unroll
        for (int e = 0; e < 8; ++e) { h0[e] = sc[e]; h1[e] = sc[DFF + e]; so[e] = h1[e]; so[DFF + e] = h2[e]; }
#pragma unroll
        for (int e = 0; e < 8; ++e) { const float hc = wf[c + e] * h0[e] + wf[DFF + c + e] * h1[e] + wf[2 * DFF + c + e] * h2[e] + bf[c + e]; y[e] = silu(hc) * hu[e]; }
        *(u32x4*)(Af + (size_t)(NP + bs) * DFF + c) = pack8(y); }
}

__device__ __forceinline__ void samp_mma(f32x4 (&acc)[4][2], const bf16_t* A, int lda, const bf16_t* Bt, int K, int j) {
    const int tid = otid(), w = tid >> 6, lane = tid & 63, fr = lane & 15, fq = lane >> 4;
    const int KS = K / 32, cb = j >> 1, rh = j & 1;
    sk_zero(acc);
    sk_mma<4, 2, false, 4>(acc, A + (size_t)(NP + 64 * rh + fr) * lda + 8 * fq, (size_t)16 * lda, Bt + (size_t)(32 * cb + fr) * K + 8 * fq, (size_t)16 * K, (w * KS) >> 3, ((w + 1) * KS) >> 3);
}

__global__ __launch_bounds__(512, 2) void mega(Params p) {
    extern __shared__ __attribute__((aligned(16))) unsigned char shm[];
    cg::grid_group grid = cg::this_grid();
    PG8_LAS unsigned char* lds = (PG8_LAS unsigned char*)shm;
    unsigned char* ws = p.ws;
    const int G = gridDim.x, bid = blockIdx.x, tid = threadIdx.x;
    bf16_t* Xb = (bf16_t*)(ws + O_XB); bf16_t* P = (bf16_t*)(ws + O_P);
    pg8::StaticOrder S;
    volatile LAS unsigned* xst = (volatile LAS unsigned*)(shm + LDS_BYTES - 32);
    if (tid == 0) { xst[0] = 0u; xst[1] = 0u; }
    __syncthreads();
    const XcdBarrier xb = xcd_barrier_post((unsigned*)(ws + O_CTRL), xst);

    for (int rep = 0; rep < REP_P0; ++rep) phase_convert(p, shm);
    if (p.ws == nullptr) grid.sync();
    xcd_barrier(xb);

    { S.init(NP, NIN, G, bid, REP_P1); EpiInproj E{P};
      pg8::gemm_phase<EpiInproj, pg8::StaticOrder>(lds, pg8::Gemm{Xb, (const bf16_t*)(ws + O_WIN), NP, NIN, D}, S, E, nullptr); }
    __syncthreads();
    for (int rep = 0; rep < REP_SK; ++rep) {
    for (int j = bid; j < 512; j += G) p1_sample_inproj(p, shm, j);
    for (int j = bid; j < 512; j += G) p1_memkv(p, shm, j);
    for (int j = bid; j < 260; j += G) p1_alr(p, shm, j); }
    xcd_barrier(xb);

    for (int rep = 0; rep < REP_P2; ++rep)
    { int* sjob = (int*)(shm + LDS_BYTES - 64); unsigned* ctr = (unsigned*)(ws + O_CTRL) + 64 * rep;
      if (bid < 128) for (int r2 = 0; r2 < REP_GLA; ++r2) gla_prompt_job(p, shm, bid);
      for (;;) {
          __syncthreads();
          if (tid == 0) *sjob = (int)atomicAdd(ctr, 1u);
          __syncthreads();
          const int q = *sjob;
          if (q >= 961) break;
          int j;
          { const int t = q / 3, r = q - 3 * t; if (r == 2) j = 640 + t; else { j = 2 * t + r; if (j >= 640) j = 960; } }
          if (j < 512) gla_sample_job(p, shm, j);
          else if (j < 640) attn_sample_job(p, shm, j - 512);
          else if (j < 896) attn_prompt_job(p, j - 640);
          else conv_job(p, j - 896);
      } }
    xcd_barrier(xb);

    phase_gla_norm(p);
    xcd_barrier(xb);

    { float* MGf = (float*)(ws + O_MGF); bf16_t* MGb = (bf16_t*)(ws + O_MGB);
      const bf16_t* Aa = (const bf16_t*)(ws + O_AA); const bf16_t* Ab = (const bf16_t*)(ws + O_AB); const bf16_t* Am = (const bf16_t*)(ws + O_AM);
      const bf16_t* Wgo = (const bf16_t*)(ws + O_WGO); const bf16_t* Wco = (const bf16_t*)(ws + O_WCO); const bf16_t* Wmo = (const bf16_t*)(ws + O_WMO);
      S.init(NP, D, G, bid);
      { EpiMerge E{P, MGf, MGb, ZA_OFF, 0}; pg8::gemm_phase<EpiMerge, pg8::StaticOrder>(lds, pg8::Gemm{Aa, Wgo, NP, D, D}, S, E, nullptr); }
      { EpiMerge E{P, MGf, MGb, ZB_OFF, 1}; pg8::gemm_phase<EpiMerge, pg8::StaticOrder>(lds, pg8::Gemm{Ab, Wco, NP, D, 1024}, S, E, nullptr); }
      { EpiMerge E{P, MGf, MGb, ZM_OFF, 2}; pg8::gemm_phase<EpiMerge, pg8::StaticOrder>(lds, pg8::Gemm{Am, Wmo, NP, D, 1024}, S, E, nullptr); }
      for (int rep = 0; rep < REP_SK; ++rep)
      for (int j = bid; j < 128; j += G) { const int cb = j >> 1, rh = j & 1;
          f32x4 fin = (f32x4){0.f, 0.f, 0.f, 0.f};
#pragma unroll
          for (int br = 0; br < 3; ++br) { f32x4 acc[4][2];
              if (br == 0) samp_mma(acc, Aa, D, Wgo, D, j); else if (br == 1) samp_mma(acc, Ab, 1024, Wco, 1024, j); else samp_mma(acc, Am, 1024, Wmo, 1024, j);
              const int zoff = br == 0 ? ZA_OFF : br == 1 ? ZB_OFF : ZM_OFF;
              sk_reduce<8>(shm, &acc[0][0], [&](int, int t, int ln, f32x4 v) { const int rt = t >> 1, ct = t & 1, r = ln & 15, q = ln >> 4;
                  const u32x2 gw = *(const u32x2*)(P + (size_t)(NP + 64 * rh + 16 * rt + r) * LDP + zoff + 32 * cb + 16 * ct + 4 * q);
                  f32x4 g; g[0] = bflo(gw.x); g[1] = bfhi(gw.x); g[2] = bflo(gw.y); g[3] = bfhi(gw.y);
                  fin = fin + g * v; }); }
          { const int s2 = otid(), t = s2 >> 6, ln = s2 & 63, rt = t >> 1, ct = t & 1, r = ln & 15, q = ln >> 4;
              u32x2 o; o.x = pk2(fin[0], fin[1]); o.y = pk2(fin[2], fin[3]);
              *(u32x2*)(MGb + (size_t)(NP + 64 * rh + 16 * rt + r) * D + 32 * cb + 16 * ct + 4 * q) = o; } } }
    xcd_barrier(xb);

    { const bf16_t* MGb = (const bf16_t*)(ws + O_MGB); const bf16_t* Wo = (const bf16_t*)(ws + O_WO); bf16_t* H1 = (bf16_t*)(ws + O_H1);
      S.init(NP, D, G, bid);
      { EpiResidB E{Xb, H1}; pg8::gemm_phase<EpiResidB, pg8::StaticOrder>(lds, pg8::Gemm{MGb, Wo, NP, D, D}, S, E, nullptr); }
      for (int rep = 0; rep < REP_SK; ++rep)
      for (int j = bid; j < 128; j += G) { f32x4 acc[4][2]; samp_mma(acc, MGb, D, Wo, D, j); const float* xs = p.in[1]; const int cb = j >> 1, rh = j & 1;
          sk_reduce<8>(shm, &acc[0][0], [&](int, int t, int ln, f32x4 v) { const int rt = t >> 1, ct = t & 1, r = 64 * rh + 16 * rt + (ln & 15), col = 32 * cb + 16 * ct + 4 * (ln >> 4);
              const f32x4 y = *(const f32x4*)(xs + (size_t)r * D + col) * DN_ALPHA + v;
              u32x2 w; w.x = pk2(y[0], y[1]); w.y = pk2(y[2], y[3]); *(u32x2*)(H1 + (size_t)(NP + r) * D + col) = w; }); } }
    xcd_barrier(xb);

    phase_ln<false>(p, (const bf16_t*)(ws + O_H1), p.in[19], p.in[20]);
    xcd_barrier(xb);

    { S.init(NRP, NGU, G, bid, REP_P6); EpiBf16 E{P, NGU};
      pg8::gemm_phase<EpiBf16, pg8::StaticOrder>(lds, pg8::Gemm{(const bf16_t*)(ws + O_X1B), (const bf16_t*)(ws + O_WGU), NRP, NGU, D}, S, E, nullptr); }
    xcd_barrier(xb);

    for (int rep = 0; rep < REP_P7; ++rep) phase_ffn_mid(p);
    xcd_barrier(xb);

    { const bf16_t* Af = (const bf16_t*)(ws + O_OG); const bf16_t* Wd = (const bf16_t*)(ws + O_WD); const bf16_t* X1r = (const bf16_t*)(ws + O_X1B); bf16_t* H2 = (bf16_t*)(ws + O_H1);
      S.init(NP, D, G, bid);
      { EpiResidB E{X1r, H2}; pg8::gemm_phase<EpiResidB, pg8::StaticOrder>(lds, pg8::Gemm{Af, Wd, NP, D, DFF}, S, E, nullptr); }
      for (int rep = 0; rep < REP_SK; ++rep)
      for (int j = bid; j < 128; j += G) { f32x4 acc[4][2]; samp_mma(acc, Af, DFF, Wd, DFF, j); const int cb = j >> 1, rh = j & 1;
          sk_reduce<8>(shm, &acc[0][0], [&](int, int t, int ln, f32x4 v) { const int rt = t >> 1, ct = t & 1;
              const size_t o = (size_t)(NP + 64 * rh + 16 * rt + (ln & 15)) * D + 32 * cb + 16 * ct + 4 * (ln >> 4);
              const u32x2 rw = *(const u32x2*)(X1r + o); f32x4 r; r[0] = bflo(rw.x); r[1] = bfhi(rw.x); r[2] = bflo(rw.y); r[3] = bfhi(rw.y);
              const f32x4 y = r * DN_ALPHA + v; u32x2 w; w.x = pk2(y[0], y[1]); w.y = pk2(y[2], y[3]); *(u32x2*)(H2 + o) = w; }); } }
    xcd_barrier(xb);

    for (int rep = 1; rep < REP_SYNC; ++rep) xcd_barrier(xb);
    phase_ln<true>(p, (const bf16_t*)(ws + O_H1), p.in[26], p.in[27]);
}

extern "C" void kernel_launch(void* const* d_in, const int* in_sizes, int n_in, void* d_out, int out_size, void* d_ws, size_t ws_size, hipStream_t stream) {
    static int grid_blocks = 0;
    if (!grid_blocks) {
        int dev = 0, cus = 0, per_cu = 0;
        (void)hipGetDevice(&dev);
        (void)hipDeviceGetAttribute(&cus, hipDeviceAttributeMultiprocessorCount, dev);
        (void)hipFuncSetAttribute((const void*)mega, hipFuncAttributeMaxDynamicSharedMemorySize, LDS_BYTES);
        (void)hipOccupancyMaxActiveBlocksPerMultiprocessor(&per_cu, mega, 512, LDS_BYTES);
        if (per_cu > 1) per_cu = 1;
        grid_blocks = cus * per_cu;
        if (grid_blocks <= 0) { fprintf(stderr, "occupancy query returned 0 (cus %d per_cu %d)\n", cus, per_cu); grid_blocks = cus > 0 ? cus : 256; }
    }
    Params p; memset(&p, 0, sizeof(p));
    for (int i = 0; i < 28; ++i) p.in[i] = (const float*)d_in[i];
    p.out = (float*)d_out; p.ws = (unsigned char*)d_ws;
    unsigned char* ws = (unsigned char*)d_ws;
    (void)hipMemsetAsync(ws + O_CTRL, 0, 16384, stream);
    void* args[] = {&p};
    hipError_t e = hipLaunchCooperativeKernel((const void*)mega, dim3(grid_blocks), dim3(512), args, LDS_BYTES, stream);
    if (e != hipSuccess) fprintf(stderr, "cooperative launch failed: %s (grid %d)\n", hipGetErrorString(e), grid_blocks);
}
```

```cpp
#include <hip/hip_runtime.h>
#include <hip/hip_cooperative_groups.h>
#include <cstdio>
#include <cstring>
namespace cg = cooperative_groups;

namespace pg8 {
#define PG8_LAS __attribute__((address_space(3)))
typedef unsigned short bf16_t;
typedef short bf16x8 __attribute__((ext_vector_type(8)));
typedef float f32x4 __attribute__((ext_vector_type(4)));
typedef unsigned u32x4 __attribute__((ext_vector_type(4)));
typedef unsigned u32x2 __attribute__((ext_vector_type(2)));
constexpr int BM = 256, BK = 64, HALF = 128, HTB = HALF * BK * 2, STAGE_BYTES = 8 * HTB, NXCD = 8, WGM = 8;
__host__ __device__ __forceinline__ int lds_byte(int r, int c) { const int st = (r >> 4) * 2 + (c >> 5), rr = r & 15, cc = c & 31, ob = rr * 64 + cc * 2; return st * 1024 + (ob ^ (((ob >> 9) & 1) << 5)); }
__host__ __device__ __forceinline__ void stage_rc(int b, int& R, int& C) { const int st = b / 1024, sb = b % 1024, swz = sb ^ (((sb >> 9) & 1) << 5); R = (st >> 1) * 16 + swz / 64; C = (st & 1) * 32 + (swz % 64) / 2; }
__host__ __device__ __forceinline__ int perm32(int rho) { const int n = rho >> 4, i = rho & 15; return 8 * (i >> 2) + 4 * n + (i & 3); }
struct Unit { int pm, pn; };
struct Gemm { const bf16_t* A; const bf16_t* Bt; int M, N, K; };
struct StaticOrder {
    int nM, nN, nwg, G, c, reps;
    __host__ __device__ void init(int M, int N, int G_, int c_, int reps_ = 1) { nM = M / BM; nN = N / BM; nwg = nM * nN; G = G_; c = c_; reps = reps_; }
    __host__ __device__ bool next(int i, Unit& u) const {
        const long L = (long)i * G + c; if (L >= (long)nwg * reps) return false;
        int wgid = (int)(L % nwg); { const int q = nwg / NXCD, r = nwg % NXCD, xcd = wgid % NXCD, off = wgid / NXCD; wgid = (xcd < r ? xcd * (q + 1) : r * (q + 1) + (xcd - r) * q) + off; }
        const int nig = WGM * nN, gid = wgid / nig, fm = gid * WGM, gsz = (nM - fm) < WGM ? (nM - fm) : WGM;
        u.pm = fm + ((wgid % nig) % gsz); u.pn = (wgid % nig) / gsz; return true;
    }
    __device__ __forceinline__ void a_ready(const Unit&) const {}
    __device__ __forceinline__ void done(const Unit&) const {}
};
__device__ __forceinline__ unsigned cvt_pk_bf16(float lo, float hi) { unsigned r; asm volatile("v_cvt_pk_bf16_f32 %0, %1, %2" : "=v"(r) : "v"(lo), "v"(hi)); return r; }

template <class Epi, class Sched, bool STAMP = false>
__device__ __forceinline__ void gemm_phase(PG8_LAS unsigned char* lds, const Gemm g, const Sched& S, const Epi& E, unsigned long long* stamps) {
    const int tid = threadIdx.x, wid = __builtin_amdgcn_readfirstlane(tid >> 6), lane = tid & 63, wr = wid >> 2, wc = wid & 3, fr = lane & 15, fq = lane >> 4;
    const int K = g.K, nt = K / BK;
    int ts_lo = 0, ts_hi = 0, nts = 0; const unsigned long long rt_entry = STAMP ? (unsigned long long)wall_clock64() : 0ull;
#define PG8_STAMP() do { if (STAMP && wid == 0 && nts < 64) { const unsigned long long _c = (unsigned long long)clock64(); \
        ts_lo = (lane == nts) ? (int)(unsigned)_c : ts_lo; ts_hi = (lane == nts) ? (int)(unsigned)(_c >> 32) : ts_hi; ++nts; } } while (0)
    PG8_STAMP();
    unsigned voffA[2], voffB[2];
#pragma unroll
    for (int i = 0; i < 2; ++i) { int R, C; stage_rc(tid * 16 + i * 8192, R, C); const int Rb = Epi::PERM ? ((R & ~31) + perm32(R & 31)) : R;
        voffA[i] = (unsigned)(R * K + C) * 2u; voffB[i] = (unsigned)(Rb * K + C) * 2u; }
    const size_t kstep = (size_t)(BK * 2);
    const size_t hstep = (size_t)HALF * K * 2;
    const size_t tstep = 2 * hstep;
    const unsigned ldsw = (unsigned)wid * 1024u;
    const int aoff = lds_byte(wr * 64 + fr, fq * 8), boff = lds_byte(wc * 32 + fr, fq * 8);
#define PG8_SA(b, h) (((b) * 2 + (h)) * HTB)
#define PG8_SB(b, h) ((4 + (b) * 2 + (h)) * HTB)
#define PG8_STAGE(bufoff, gbase, voff) do { _Pragma("unroll") for (int _i = 0; _i < 2; ++_i) \
        __builtin_amdgcn_global_load_lds((const unsigned*)((const char*)(gbase) + (voff)[_i]), (PG8_LAS unsigned*)(lds + (bufoff) + ldsw + _i * 8192), 16, 0, 0); } while (0)
#define PG8_LDA(dst, b, h) do { _Pragma("unroll") for (int m = 0; m < 4; ++m) _Pragma("unroll") for (int k = 0; k < 2; ++k) dst[m][k] = *(const PG8_LAS bf16x8*)(lds + PG8_SA(b, h) + aoff + m * 2048 + k * 1024); } while (0)
#define PG8_LDB(dst, b, h) do { _Pragma("unroll") for (int n = 0; n < 2; ++n) _Pragma("unroll") for (int k = 0; k < 2; ++k) dst[n][k] = *(const PG8_LAS bf16x8*)(lds + PG8_SB(b, h) + boff + n * 2048 + k * 1024); } while (0)
#define PG8_MMA(ai, bj, At, Bt) do { __builtin_amdgcn_s_setprio(1); _Pragma("unroll") for (int m = 0; m < 4; ++m) _Pragma("unroll") for (int n = 0; n < 2; ++n) _Pragma("unroll") for (int k = 0; k < 2; ++k) \
        acc[ai][bj][m][n] = __builtin_amdgcn_mfma_f32_16x16x32_bf16(Bt[n][k], At[m][k], acc[ai][bj][m][n], 0, 0, 0); __builtin_amdgcn_s_setprio(0); } while (0)
#define PG8_WAIT_V(n) asm volatile("s_waitcnt vmcnt(" #n ")" ::: "memory")
#define PG8_WAIT_L(n) asm volatile("s_waitcnt lgkmcnt(" #n ")" ::: "memory")
#define PG8_BAR __builtin_amdgcn_s_barrier()
#define PG8_SCHED __builtin_amdgcn_sched_barrier(0)
    Unit cur, nxt; int ui = 0;
    if (!S.next(0, cur)) return;
    f32x4 acc[2][2][4][2];
#pragma unroll
    for (int a = 0; a < 2; ++a)
#pragma unroll
        for (int b = 0; b < 2; ++b)
#pragma unroll
            for (int m = 0; m < 4; ++m)
#pragma unroll
                for (int n = 0; n < 2; ++n) acc[a][b][m][n] = (f32x4){0.f, 0.f, 0.f, 0.f};
    bf16x8 At[4][2], B0[2][2], B1[2][2];
    const char* cA = (const char*)g.A + (size_t)cur.pm * tstep; const char* cB = (const char*)g.Bt + (size_t)cur.pn * tstep;
    S.a_ready(cur);
    PG8_STAGE(PG8_SB(0, 0), cB, voffB); PG8_STAGE(PG8_SA(0, 0), cA, voffA); PG8_STAGE(PG8_SB(0, 1), cB + hstep, voffB); PG8_STAGE(PG8_SA(0, 1), cA + hstep, voffA);
    if (wr == 1) PG8_BAR;
    PG8_WAIT_V(4); PG8_BAR;
    PG8_STAGE(PG8_SB(1, 0), cB + kstep, voffB); PG8_STAGE(PG8_SA(1, 0), cA + kstep, voffA); PG8_STAGE(PG8_SB(1, 1), cB + hstep + kstep, voffB);
    PG8_WAIT_V(6); PG8_BAR;
    PG8_STAMP();
    for (;;) {
        const bool has_next = S.next(ui + 1, nxt);
        const char* nA = has_next ? (const char*)g.A + (size_t)nxt.pm * tstep : cA; const char* nB = has_next ? (const char*)g.Bt + (size_t)nxt.pn * tstep : cB;
        for (int t = 0; t < nt; t += 2) {
            const bool last = (t == nt - 2);
            const char* a1 = cA + (size_t)(t + 1) * kstep;
            const char* a2 = last ? nA : cA + (size_t)(t + 2) * kstep; const char* b2 = last ? nB : cB + (size_t)(t + 2) * kstep;
            const char* a3 = a2 + kstep; const char* b3 = b2 + kstep;
            if (last && has_next) S.a_ready(nxt);
            PG8_LDB(B0, 0, 0); PG8_SCHED; PG8_LDA(At, 0, 0); PG8_STAGE(PG8_SA(1, 1), a1 + hstep, voffA);
            PG8_WAIT_L(8); PG8_BAR; PG8_WAIT_L(0); PG8_MMA(0, 0, At, B0); PG8_BAR; PG8_SCHED;
            PG8_LDB(B1, 0, 1); PG8_STAGE(PG8_SB(0, 0), b2, voffB);
            PG8_BAR; PG8_WAIT_L(0); PG8_MMA(0, 1, At, B1); PG8_BAR;
            PG8_LDA(At, 0, 1); PG8_STAGE(PG8_SA(0, 0), a2, voffA);
            PG8_BAR; PG8_WAIT_L(0); PG8_MMA(1, 0, At, B0); PG8_BAR; PG8_SCHED;
            PG8_STAGE(PG8_SB(0, 1), b2 + hstep, voffB);
            PG8_WAIT_V(6); PG8_BAR; PG8_MMA(1, 1, At, B1); PG8_BAR;
            PG8_LDB(B0, 1, 0); PG8_SCHED; PG8_LDA(At, 1, 0); PG8_STAGE(PG8_SA(0, 1), a2 + hstep, voffA);
            PG8_WAIT_L(8); PG8_BAR; PG8_WAIT_L(0); PG8_MMA(0, 0, At, B0); PG8_BAR; PG8_SCHED;
            PG8_LDB(B1, 1, 1); PG8_STAGE(PG8_SB(1, 0), b3, voffB);
            PG8_BAR; PG8_WAIT_L(0); PG8_MMA(0, 1, At, B1); PG8_BAR;
            PG8_LDA(At, 1, 1); PG8_STAGE(PG8_SA(1, 0), a3, voffA);
            PG8_BAR; PG8_WAIT_L(0); PG8_MMA(1, 0, At, B0); PG8_BAR; PG8_SCHED;
            PG8_STAGE(PG8_SB(1, 1), b3 + hstep, voffB);
            PG8_WAIT_V(6); PG8_BAR; PG8_MMA(1, 1, At, B1); PG8_BAR;
        }
        PG8_STAMP();
        if constexpr (!Epi::AFTER_DRAIN) { E(acc, cur, wr, wc, fr, fq); S.done(cur); }
        PG8_STAMP();
        if (!has_next) break;
#pragma unroll
        for (int a = 0; a < 2; ++a)
#pragma unroll
            for (int b = 0; b < 2; ++b)
#pragma unroll
                for (int m = 0; m < 4; ++m)
#pragma unroll
                    for (int n = 0; n < 2; ++n) acc[a][b][m][n] = (f32x4){0.f, 0.f, 0.f, 0.f};
        cur = nxt; cA = nA; cB = nB; ++ui;
    }
    PG8_WAIT_V(0);
    if (wr == 0) PG8_BAR;
    PG8_BAR;
    if constexpr (Epi::AFTER_DRAIN) { E.fused(acc, cur, wr, wc, fr, fq, lds, wid, lane); S.done(cur); }
    PG8_STAMP();
    if (STAMP && wid == 0) { stamps[lane] = lane < nts ? (((unsigned long long)(unsigned)ts_hi << 32) | (unsigned)ts_lo) : 0ull;
        if (lane == 62) stamps[62] = rt_entry; if (lane == 63) stamps[63] = (unsigned long long)wall_clock64(); }
#undef PG8_STAMP
#undef PG8_SA
#undef PG8_SB
#undef PG8_STAGE
#undef PG8_LDA
#undef PG8_LDB
#undef PG8_MMA
#undef PG8_WAIT_V
#undef PG8_WAIT_L
#undef PG8_BAR
#undef PG8_SCHED
}
}

using pg8::bf16_t; using pg8::bf16x8; using pg8::f32x4; using pg8::u32x4; using pg8::u32x2;

constexpr int D = 2048, NP = 8192, NS = 128, NR = 8320, NRP = 8448;
constexpr int NIN = 16384, LDP = 16384 + 64, WIN_LD = 16400;
constexpr int DFF = 5504, NGU = 11008;
constexpr int Q_OFF = 0, K_OFF = 1024, V_OFF = 2048, G_OFF = 4096, CB_OFF = 6144, CC_OFF = 7168, CH_OFF = 8192, MQ_OFF = 9216, ZA_OFF = 10240, ZB_OFF = 12288, ZM_OFF = 14336;
constexpr float DN_ALPHA = 1.189207115002721f;
constexpr int LDS_BYTES = 158 * 1024;
#ifndef PROBE
#define PROBE 0
#endif
constexpr int REP_P0 = (PROBE == 1) ? 2 : 1, REP_P2 = (PROBE == 2) ? 2 : 1, REP_SK = (PROBE == 3) ? 2 : 1, REP_P7 = (PROBE == 4) ? 2 : 1, REP_GLA = (PROBE == 5) ? 2 : 1, REP_P6 = (PROBE == 7) ? 2 : 1, REP_P1 = (PROBE == 8) ? 2 : 1, REP_SYNC = (PROBE == 9) ? 11 : 1;

constexpr size_t O_CTRL = 0;
constexpr size_t O_XB   = 32768;
constexpr size_t O_MEMB = O_XB + (size_t)NRP * D * 2;
constexpr size_t O_WIN  = O_MEMB + (size_t)1024 * D * 2;
constexpr size_t O_WALR = O_WIN + (size_t)NIN * D * 2;
constexpr size_t O_WGO  = O_WALR + (size_t)16 * D * 2;
constexpr size_t O_WCO  = O_WGO + (size_t)D * D * 2;
constexpr size_t O_WMO  = O_WCO + (size_t)D * 1024 * 2;
constexpr size_t O_WO   = O_WMO + (size_t)D * 1024 * 2;
constexpr size_t O_WMKV = O_WO + (size_t)D * D * 2;
constexpr size_t O_WGU  = O_WMKV + (size_t)D * D * 2;
constexpr size_t O_WD   = O_WGU + (size_t)NGU * D * 2;
constexpr size_t O_P    = O_WD + (size_t)D * DFF * 2;
constexpr size_t O_BC   = O_P + (size_t)NR * LDP * 2;
constexpr size_t O_MKB  = O_BC + (size_t)NR * 1024 * 4;
constexpr size_t O_MVT  = O_MKB + (size_t)1024 * 1024 * 2;
constexpr size_t O_OG   = O_MVT + (size_t)1024 * 1024 * 2;
constexpr size_t O_MGF  = O_OG + (size_t)NR * D * 4;
constexpr size_t O_AA   = O_MGF + (size_t)NP * D * 4;
constexpr size_t O_AB   = O_AA + (size_t)NR * D * 2;
constexpr size_t O_AM   = O_AB + (size_t)NR * 1024 * 2;
constexpr size_t O_MGB  = O_AM + (size_t)NR * 1024 * 2;
constexpr size_t O_H1   = O_MGB + (size_t)NR * D * 2;
constexpr size_t O_X1F  = O_H1 + (size_t)NR * D * 4;
constexpr size_t O_X1B  = O_X1F + (size_t)NR * D * 4;
constexpr size_t WS_TOTAL = O_X1B + (size_t)NRP * D * 2;
static_assert(WS_TOTAL <= (size_t)1073741824, "workspace too large");
static_assert((size_t)NRP * NGU * 2 <= (size_t)NR * LDP * 2, "HGU alias");
static_assert((size_t)NR * DFF * 2 <= (size_t)NR * D * 4 + (size_t)NP * D * 4, "A_ffn alias");

constexpr size_t OUT_YP = 0;
constexpr size_t OUT_YS = OUT_YP + (size_t)NP * D;
constexpr size_t OUT_PMK = OUT_YS + (size_t)NS * D;
constexpr size_t OUT_PMV = OUT_PMK + (size_t)1024 * 1024;
constexpr size_t OUT_PGLA = OUT_PMV + (size_t)1024 * 1024;
constexpr size_t OUT_PCONV = OUT_PGLA + (size_t)4 * 4 * 256 * 512;
constexpr size_t OUT_PFFN = OUT_PCONV + (size_t)4 * 2 * 1024;
constexpr size_t OUT_SGLA = OUT_PFFN + (size_t)4 * 2 * DFF;
constexpr size_t OUT_SCONV = OUT_SGLA + (size_t)NS * 4 * 256 * 512;
constexpr size_t OUT_SFFN = OUT_SCONV + (size_t)NS * 2 * 1024;

struct Params {
    const float* in[28];
    float* out;
    unsigned char* ws;
};
constexpr int TB1 = 768, TB2 = 2048, TB3 = 2304, TB4 = 2432, TB5 = 2560, TB6 = 2688, TB7 = 2816, TB8 = 3072, TB9 = 3760, TB10 = 4448, NTILES = 5136;

typedef __bf16 bf16x2_t __attribute__((ext_vector_type(2)));
typedef float f32x2_t __attribute__((ext_vector_type(2)));
__device__ __forceinline__ unsigned pk2(float lo, float hi) { f32x2_t v = {lo, hi}; bf16x2_t b = __builtin_convertvector(v, bf16x2_t); return __builtin_bit_cast(unsigned, b); }
__device__ __forceinline__ float bflo(unsigned w) { return __uint_as_float(w << 16); }
__device__ __forceinline__ float bfhi(unsigned w) { return __uint_as_float(w & 0xffff0000u); }
__device__ __forceinline__ float bf2f(bf16_t b) { return __uint_as_float(((unsigned)b) << 16); }
__device__ __forceinline__ float sigm(float x) { return __builtin_amdgcn_rcpf(1.0f + __expf(-x)); }
__device__ __forceinline__ float silu(float x) { return x * __builtin_amdgcn_rcpf(1.0f + __expf(-x)); }
__device__ __forceinline__ int otid() { int t = threadIdx.x; asm volatile("" : "+v"(t)); return t; }
__device__ __forceinline__ float wave_sum(float v) { for (int o = 32; o >= 1; o >>= 1) v += __shfl_xor(v, o); return v; }
__device__ __forceinline__ f32x4 mfma16(bf16x8 x, bf16x8 y, f32x4 c) { return __builtin_amdgcn_mfma_f32_16x16x32_bf16(x, y, c, 0, 0, 0); }
__device__ __forceinline__ bf16x8 ld8(const bf16_t* p) { return *(const bf16x8*)p; }
__device__ __forceinline__ void unpack8(u32x4 w, float (&f)[8]) { f[0] = bflo(w.x); f[1] = bfhi(w.x); f[2] = bflo(w.y); f[3] = bfhi(w.y); f[4] = bflo(w.z); f[5] = bfhi(w.z); f[6] = bflo(w.w); f[7] = bfhi(w.w); }
__device__ __forceinline__ u32x4 pack8(const float (&f)[8]) { u32x4 w; w.x = pk2(f[0], f[1]); w.y = pk2(f[2], f[3]); w.z = pk2(f[4], f[5]); w.w = pk2(f[6], f[7]); return w; }

__device__ __forceinline__ int inproj_mode(int col) { return col < 1024 ? 1 : col < 4096 ? 0 : col < 6144 ? 2 : col < 9216 ? 0 : col < 10240 ? 1 : 3; }
__device__ __forceinline__ f32x4 inproj_act(f32x4 v, int mode) {
    if (mode == 1) { v = v * 0.0625f; }
    else if (mode == 2) { v[0] = silu(v[0]); v[1] = silu(v[1]); v[2] = silu(v[2]); v[3] = silu(v[3]); }
    else if (mode == 3) { v[0] = sigm(v[0]); v[1] = sigm(v[1]); v[2] = sigm(v[2]); v[3] = sigm(v[3]); }
    return v;
}

#define XB_TMO      128
#define XB_XCNT(j)  (256  + 64 * (j))
#define XB_XSUB(j)  (1280 + 64 * (j))
#define XB_XGEN(j)  (2304 + 64 * (j))
#define XB_TOP      3328
#define XB_TOPGEN   3392
#define XCD_BAR_WORDS 3456
#define XB_SPIN_CAP (1u << 18)
#define LAS __attribute__((address_space(3)))

__device__ __forceinline__ unsigned xb_ld(unsigned* p)              { return __hip_atomic_load(p, __ATOMIC_RELAXED, __HIP_MEMORY_SCOPE_AGENT); }
__device__ __forceinline__ unsigned xb_add(unsigned* p, unsigned v) { return __hip_atomic_fetch_add(p, v, __ATOMIC_RELAXED, __HIP_MEMORY_SCOPE_AGENT); }
__device__ __forceinline__ unsigned xb_xcc_id() { return (unsigned)__builtin_amdgcn_s_getreg((3 << 11) | 20) & 0xFu; }
#define XB_SPIN(cond, bar) do { unsigned _sp = 0; while (cond) { __builtin_amdgcn_s_sleep(1); \
    if ((++_sp & 255u) == 0u) { if (xb_ld(&(bar)[XB_TMO])) break; if (_sp > XB_SPIN_CAP) { atomicAdd(&(bar)[XB_TMO], 1u); break; } } } } while (0)

struct XcdBarrier {
    unsigned* bar; unsigned x;
    volatile LAS unsigned* st;
};

__device__ __forceinline__ XcdBarrier xcd_barrier_post(unsigned* bar, volatile LAS unsigned* st) {
    XcdBarrier b; b.bar = bar; b.x = xb_xcc_id(); b.st = st;
    if (threadIdx.x == 0) (void)xb_add(&bar[XB_XCNT(b.x)], 1u);
    return b;
}
__device__ __forceinline__ void xcd_barrier_complete(unsigned* bar, unsigned x, unsigned& nloc, unsigned& nx) {
    const unsigned G = gridDim.x * gridDim.y * gridDim.z;
    unsigned sum, cnt, mine, sp = 0u;
    for (;;) {
        sum = 0u; cnt = 0u; mine = 0u;
#pragma unroll
        for (unsigned j = 0; j < 16; ++j) { const unsigned c = xb_ld(&bar[XB_XCNT(j)]); sum += c; cnt += (c > 0u) ? 1u : 0u; mine = (j == x) ? c : mine; }
        if (sum == G) break;
        __builtin_amdgcn_s_sleep(1);
        if ((++sp & 255u) == 0u) { if (xb_ld(&bar[XB_TMO])) break; if (sp > XB_SPIN_CAP) { atomicAdd(&bar[XB_TMO], 1u); break; } }
    }
    nloc = mine > 0u ? mine : 1u; nx = cnt > 0u ? cnt : 1u;
}

__device__ __forceinline__ void xcd_barrier(const XcdBarrier& b) {
    asm volatile("s_waitcnt vmcnt(0)" ::: "memory");
    __syncthreads();
    if (threadIdx.x == 0) {
        unsigned* bar = b.bar;
        __builtin_amdgcn_s_waitcnt(0);
        unsigned nloc = b.st[0], nx = b.st[1];
        if (nloc == 0u) { xcd_barrier_complete(bar, b.x, nloc, nx); b.st[0] = nloc; b.st[1] = nx; }
        const unsigned old = xb_add(&bar[XB_XSUB(b.x)], 1u);
        const unsigned gen = old / nloc;
        if (old + 1u == (gen + 1u) * nloc) {
            __builtin_amdgcn_fence(__ATOMIC_RELEASE, "agent");
            asm volatile("s_waitcnt vmcnt(0)" ::: "memory");
            const unsigned og = xb_add(&bar[XB_TOP], 1u);
            const unsigned tg = og / nx;
            if (og + 1u == (tg + 1u) * nx) xb_add(&bar[XB_TOPGEN], 1u);
            else XB_SPIN(xb_ld(&bar[XB_TOPGEN]) == tg, bar);
            __builtin_amdgcn_fence(__ATOMIC_ACQUIRE, "agent");
            xb_add(&bar[XB_XGEN(b.x)], 1u);
            asm volatile("s_waitcnt vmcnt(0)" ::: "memory");
        } else {
            XB_SPIN(xb_ld(&bar[XB_XGEN(b.x)]) == gen, bar);
            __builtin_amdgcn_fence(__ATOMIC_ACQUIRE, "agent");
            asm volatile("s_waitcnt vmcnt(0)" ::: "memory");
        }
    }
    __syncthreads();
}

struct EpiInproj {
    static constexpr bool PERM = true, AFTER_DRAIN = false;
    bf16_t* O;
    template <bool SIG> __device__ __forceinline__ void body(const f32x4 (&acc)[2][2][4][2], bf16_t* base, float ca, float cb, float cc) const {
#pragma unroll
        for (int ai = 0; ai < 2; ++ai)
#pragma unroll
            for (int m = 0; m < 4; ++m) { bf16_t* rowp = base + (size_t)(ai * 128 + m * 16) * LDP;
#pragma unroll
                for (int bj = 0; bj < 2; ++bj) { float y[8];
#pragma unroll
                    for (int e = 0; e < 8; ++e) { const float x = e < 4 ? acc[ai][bj][m][0][e & 3] : acc[ai][bj][m][1][e & 3];
                        if (SIG) { const float sg = __builtin_amdgcn_rcpf(1.0f + __expf(-x)); y[e] = sg * (cb + cc * x); }
                        else y[e] = ca * x; }
                    __builtin_nontemporal_store(pack8(y), (u32x4*)(rowp + bj * 128)); } }
    }
    __device__ __forceinline__ void operator()(const f32x4 (&acc)[2][2][4][2], const pg8::Unit& u, int wr, int wc, int fr, int fq) const {
        const int mode = inproj_mode(u.pn * 256);
        const float ca = mode == 1 ? 0.0625f : 1.0f, cb = mode == 3 ? 1.0f : 0.0f, cc = mode == 2 ? 1.0f : 0.0f;
        bf16_t* base = O + (size_t)(u.pm * 256 + wr * 64 + fr) * LDP + u.pn * 256 + wc * 32 + 8 * fq;
        if (mode >= 2) body<true>(acc, base, ca, cb, cc); else body<false>(acc, base, ca, cb, cc);
    }
};
struct EpiBf16 {
    static constexpr bool PERM = true, AFTER_DRAIN = false;
    bf16_t* O; int ldc;
    __device__ __forceinline__ void operator()(const f32x4 (&acc)[2][2][4][2], const pg8::Unit& u, int wr, int wc, int fr, int fq) const {
        const int row0 = u.pm * 256 + wr * 64 + fr, col0 = u.pn * 256 + wc * 32 + 8 * fq;
#pragma unroll
        for (int ai = 0; ai < 2; ++ai)
#pragma unroll
            for (int m = 0; m < 4; ++m) { bf16_t* rowp = O + (size_t)(row0 + ai * 128 + m * 16) * ldc + col0;
#pragma unroll
                for (int bj = 0; bj < 2; ++bj) { const f32x4 v0 = acc[ai][bj][m][0], v1 = acc[ai][bj][m][1];
                    u32x4 w; w.x = pk2(v0[0], v0[1]); w.y = pk2(v0[2], v0[3]); w.z = pk2(v1[0], v1[1]); w.w = pk2(v1[2], v1[3]);
                    *(u32x4*)(rowp + bj * 128) = w; } }
    }
};
struct EpiMerge {
    static constexpr bool PERM = true, AFTER_DRAIN = false;
    const bf16_t* P; float* MGf; bf16_t* MGb; int zoff, mode;
    __device__ __forceinline__ void operator()(const f32x4 (&acc)[2][2][4][2], const pg8::Unit& u, int wr, int wc, int fr, int fq) const {
        const int row0 = u.pm * 256 + wr * 64 + fr, col0 = u.pn * 256 + wc * 32 + 8 * fq;
#pragma unroll
        for (int ai = 0; ai < 2; ++ai)
#pragma unroll
            for (int m = 0; m < 4; ++m) { const size_t row = (size_t)(row0 + ai * 128 + m * 16);
#pragma unroll
                for (int bj = 0; bj < 2; ++bj) { const int col = col0 + bj * 128;
                    float g[8], v[8]; unpack8(__builtin_nontemporal_load((const u32x4*)(P + row * LDP + zoff + col)), g);
#pragma unroll
                    for (int e = 0; e < 4; ++e) { v[e] = g[e] * acc[ai][bj][m][0][e]; v[4 + e] = g[4 + e] * acc[ai][bj][m][1][e]; }
                    bf16_t* mp = MGb + row * D + col;
                    if (mode != 0) { float pv[8]; unpack8(*(const u32x4*)mp, pv);
#pragma unroll
                        for (int e = 0; e < 8; ++e) v[e] += pv[e]; }
                    *(u32x4*)mp = pack8(v); } }
    }
};
struct EpiResid {
    static constexpr bool PERM = false, AFTER_DRAIN = false;
    const float* resid; bf16_t* out;
    __device__ __forceinline__ void operator()(const f32x4 (&acc)[2][2][4][2], const pg8::Unit& u, int wr, int wc, int fr, int fq) const {
        const int row0 = u.pm * 256 + wr * 64 + fr, col0 = u.pn * 256 + wc * 32 + 4 * fq;
#pragma unroll
        for (int ai = 0; ai < 2; ++ai)
#pragma unroll
            for (int m = 0; m < 4; ++m) { const size_t ro = (size_t)(row0 + ai * 128 + m * 16) * D + col0;
#pragma unroll
                for (int bj = 0; bj < 2; ++bj)
#pragma unroll
                    for (int n = 0; n < 2; ++n) { const size_t o = ro + bj * 128 + n * 16;
                        const f32x4 y = *(const f32x4*)(resid + o) * DN_ALPHA + acc[ai][bj][m][n];
                        u32x2 w; w.x = pk2(y[0], y[1]); w.y = pk2(y[2], y[3]); *(u32x2*)(out + o) = w; } }
    }
};

struct EpiResidB {
    static constexpr bool PERM = true, AFTER_DRAIN = false;
    const bf16_t* resid; bf16_t* out;
    __device__ __forceinline__ void operator()(const f32x4 (&acc)[2][2][4][2], const pg8::Unit& u, int wr, int wc, int fr, int fq) const {
        const int row0 = u.pm * 256 + wr * 64 + fr, col0 = u.pn * 256 + wc * 32 + 8 * fq;
#pragma unroll
        for (int ai = 0; ai < 2; ++ai)
#pragma unroll
            for (int m = 0; m < 4; ++m) { const size_t ro = (size_t)(row0 + ai * 128 + m * 16) * D + col0;
#pragma unroll
                for (int bj = 0; bj < 2; ++bj) { const size_t o = ro + bj * 128;
                    float r[8], y[8]; unpack8(__builtin_nontemporal_load((const u32x4*)(resid + o)), r);
#pragma unroll
                    for (int e = 0; e < 4; ++e) { y[e] = r[e] * DN_ALPHA + acc[ai][bj][m][0][e]; y[4 + e] = r[4 + e] * DN_ALPHA + acc[ai][bj][m][1][e]; }
                    *(u32x4*)(out + o) = pack8(y); } }
    }
};
template <int RT, int CT, bool SWAP, int UNR = 2>
__device__ __forceinline__ void sk_mma(f32x4 (&acc)[RT][CT], const bf16_t* ap, size_t astep, const bf16_t* bp, size_t bstep, int ks0, int ks1) {
    int ks = ks0;
    for (; ks + UNR <= ks1; ks += UNR) {
        bf16x8 a[UNR][RT], b[UNR][CT];
#pragma unroll
        for (int u = 0; u < UNR; ++u) {
#pragma unroll
            for (int r = 0; r < RT; ++r) a[u][r] = ld8(ap + r * astep + 32 * (ks + u));
#pragma unroll
            for (int c = 0; c < CT; ++c) b[u][c] = ld8(bp + c * bstep + 32 * (ks + u)); }
#pragma unroll
        for (int u = 0; u < UNR; ++u)
#pragma unroll
            for (int r = 0; r < RT; ++r)
#pragma unroll
                for (int c = 0; c < CT; ++c) acc[r][c] = SWAP ? mfma16(a[u][r], b[u][c], acc[r][c]) : mfma16(b[u][c], a[u][r], acc[r][c]);
    }
    if (UNR > 2 && ks + 2 <= ks1) {
        bf16x8 a[2][RT], b[2][CT];
#pragma unroll
        for (int u = 0; u < 2; ++u) {
#pragma unroll
            for (int r = 0; r < RT; ++r) a[u][r] = ld8(ap + r * astep + 32 * (ks + u));
#pragma unroll
            for (int c = 0; c < CT; ++c) b[u][c] = ld8(bp + c * bstep + 32 * (ks + u)); }
#pragma unroll
        for (int u = 0; u < 2; ++u)
#pragma unroll
            for (int r = 0; r < RT; ++r)
#pragma unroll
                for (int c = 0; c < CT; ++c) acc[r][c] = SWAP ? mfma16(a[u][r], b[u][c], acc[r][c]) : mfma16(b[u][c], a[u][r], acc[r][c]);
        ks += 2;
    }
    for (; ks < ks1; ++ks) {
        bf16x8 a[RT], b[CT];
#pragma unroll
        for (int r = 0; r < RT; ++r) a[r] = ld8(ap + r * astep + 32 * ks);
#pragma unroll
        for (int c = 0; c < CT; ++c) b[c] = ld8(bp + c * bstep + 32 * ks);
#pragma unroll
        for (int r = 0; r < RT; ++r)
#pragma unroll
            for (int c = 0; c < CT; ++c) acc[r][c] = SWAP ? mfma16(a[r], b[c], acc[r][c]) : mfma16(b[c], a[r], acc[r][c]);
    }
}
template <int NTILE, class F>
__device__ __forceinline__ void sk_reduce(unsigned char* smem, const f32x4* acc, F&& epi) {
    f32x4* red = (f32x4*)smem; const int tid = otid(), w = tid >> 6, lane = tid & 63;
#pragma unroll
    for (int t = 0; t < NTILE; ++t) red[(w * NTILE + t) * 64 + lane] = acc[t];
    __syncthreads();
#pragma unroll
    for (int i = 0; i < (NTILE * 64 + 511) / 512; ++i) { const int s = tid + 512 * i;
        if (s < NTILE * 64) { f32x4 v = red[s];
#pragma unroll
            for (int wv = 1; wv < 8; ++wv) v = v + red[wv * NTILE * 64 + s];
            epi(i, s >> 6, s & 63, v); } }
    __syncthreads();
}
template <int RT, int CT> __device__ __forceinline__ void sk_zero(f32x4 (&acc)[RT][CT]) {
#pragma unroll
    for (int r = 0; r < RT; ++r)
#pragma unroll
        for (int c = 0; c < CT; ++c) acc[r][c] = (f32x4){0.f, 0.f, 0.f, 0.f};
}

__device__ __forceinline__ void phase_convert(const Params& p, unsigned char* smem) {
    float* T = (float*)smem;
    const int tid = otid(), G = gridDim.x;
    unsigned char* ws = p.ws;
    f32x4 pre[8];
    auto issue = [&](int tile, const float*& src, bf16_t*& dst, int& K, int& k0, int& n0) {
        src = p.in[8]; dst = (bf16_t*)(ws + O_WIN); int src_ld = WIN_LD, c0 = 0, ntn = 48, tb = 0; K = D;
#define TDSEL(TB, SRC, DST, LD, C0, KK, NN) if (tile >= (TB)) { src = (SRC); dst = (bf16_t*)(DST); src_ld = (LD); c0 = (C0); K = (KK); ntn = (NN) / 128; tb = (TB); }
        TDSEL(TB1, p.in[8], ws + O_WIN + (size_t)6144 * D * 2, WIN_LD, 6160, D, 10240)
        TDSEL(TB2, p.in[12], ws + O_WGO, D, 0, D, D)
        TDSEL(TB3, p.in[14], ws + O_WCO, D, 0, 1024, D)
        TDSEL(TB4, p.in[15], ws + O_WMKV, 1024, 0, D, 1024)
        TDSEL(TB5, p.in[16], ws + O_WMKV + (size_t)1024 * D * 2, 1024, 0, D, 1024)
        TDSEL(TB6, p.in[17], ws + O_WMO, D, 0, 1024, D)
        TDSEL(TB7, p.in[18], ws + O_WO, D, 0, D, D)
        TDSEL(TB8, p.in[21], ws + O_WGU, DFF, 0, D, DFF)
        TDSEL(TB9, p.in[22], ws + O_WGU + (size_t)DFF * D * 2, DFF, 0, D, DFF)
        TDSEL(TB10, p.in[25], ws + O_WD, D, 0, DFF, D)
#undef TDSEL
        const int lt = tile - tb, kt = lt / ntn, nt = lt - kt * ntn; k0 = kt * 128; n0 = nt * 128;
#pragma unroll
        for (int i = 0; i < 8; ++i) { const int f = tid + 512 * i, kk = f >> 5, n4 = f & 31;
            pre[i] = __builtin_nontemporal_load((const f32x4*)(src + (size_t)(k0 + kk) * src_ld + c0 + n0 + 4 * n4)); }
    };
    const float* src; bf16_t* dst; int K, k0, n0;
    auto tmap = [](int idx) { return idx + TB2 < NTILES ? idx + TB2 : idx + TB2 - NTILES; };
    if ((int)blockIdx.x < NTILES) issue(tmap(blockIdx.x), src, dst, K, k0, n0);
    for (int tile = blockIdx.x; tile < NTILES; tile += G) {
#pragma unroll
        for (int i = 0; i < 8; ++i) { const int f = tid + 512 * i, kk = f >> 5, n4 = f & 31; float* tp = T + kk * 133 + 4 * n4;
            tp[0] = pre[i][0]; tp[1] = pre[i][1]; tp[2] = pre[i][2]; tp[3] = pre[i][3]; }
        bf16_t* cdst = dst; const int cK = K, ck0 = k0, cn0 = n0;
        __syncthreads();
        if (tile + G < NTILES) issue(tmap(tile + G), src, dst, K, k0, n0);
#pragma unroll
        for (int i = 0; i < 4; ++i) { const int it = tid + 512 * i, kg = it & 15, n = it >> 4;
            float f[8];
#pragma unroll
            for (int e = 0; e < 8; ++e) f[e] = T[(8 * kg + e) * 133 + n];
            *(u32x4*)(cdst + (size_t)(cn0 + n) * cK + ck0 + 8 * kg) = pack8(f); }
        __syncthreads();
    }
    bf16_t* Xb = (bf16_t*)(ws + O_XB); bf16_t* Memb = (bf16_t*)(ws + O_MEMB); bf16_t* X1b = (bf16_t*)(ws + O_X1B); bf16_t* Walr = (bf16_t*)(ws + O_WALR);
    const size_t stride = (size_t)G * 512, t0 = (size_t)blockIdx.x * 512 + tid;
    for (size_t it = t0; it < (size_t)NRP * 256; it += stride) { const int row = (int)(it >> 8), c8 = (int)(it & 255) * 8;
        u32x4 w = {0u, 0u, 0u, 0u};
        if (row < NR) { const float* s = row < NP ? p.in[0] + (size_t)row * D + c8 : p.in[1] + (size_t)(row - NP) * D + c8;
            const f32x4 a = *(const f32x4*)s, b = *(const f32x4*)(s + 4);
            w.x = pk2(a[0], a[1]); w.y = pk2(a[2], a[3]); w.z = pk2(b[0], b[1]); w.w = pk2(b[2], b[3]); }
        else { *(u32x4*)(X1b + (size_t)row * D + c8) = w; }
        *(u32x4*)(Xb + (size_t)row * D + c8) = w; }
    for (size_t it = t0; it < (size_t)1024 * 256; it += stride) { const float* s = p.in[2] + it * 8;
        const f32x4 a = *(const f32x4*)s, b = *(const f32x4*)(s + 4); u32x4 w;
        w.x = pk2(a[0], a[1]); w.y = pk2(a[2], a[3]); w.z = pk2(b[0], b[1]); w.w = pk2(b[2], b[3]);
        *(u32x4*)(Memb + it * 8) = w; }
    for (size_t it = t0; it < (size_t)16 * D; it += stride) { const int r = (int)(it >> 11), k = (int)(it & 2047);
        const float v = p.in[8][(size_t)k * WIN_LD + 6144 + r]; Walr[it] = (bf16_t)(pk2(v, 0.f) & 0xffffu); }
}

__device__ __forceinline__ void p1_sample_inproj(const Params& p, unsigned char* smem, int j) {
    const int tid = otid(), w = tid >> 6, lane = tid & 63, fr = lane & 15, fq = lane >> 4;
    const bf16_t* Xb = (const bf16_t*)(p.ws + O_XB); const bf16_t* Win = (const bf16_t*)(p.ws + O_WIN); bf16_t* P = (bf16_t*)(p.ws + O_P);
    const int col0 = 64 * (j >> 1), row0 = NP + 64 * (j & 1);
    f32x4 acc[4][4]; sk_zero(acc);
    sk_mma<4, 4, false, 2>(acc, Xb + (size_t)(row0 + fr) * D + 8 * fq, (size_t)16 * D, Win + (size_t)(col0 + fr) * D + 8 * fq, (size_t)16 * D, 8 * w, 8 * w + 8);
    const int mode = inproj_mode(col0);
    sk_reduce<16>(smem, &acc[0][0], [&](int, int t, int ln, f32x4 v) { const int rt = t >> 2, ct = t & 3, r = ln & 15, q = ln >> 4;
        v = inproj_act(v, mode); u32x2 o; o.x = pk2(v[0], v[1]); o.y = pk2(v[2], v[3]);
        *(u32x2*)(P + (size_t)(row0 + 16 * rt + r) * LDP + col0 + 16 * ct + 4 * q) = o; });
}
__device__ __forceinline__ void p1_memkv(const Params& p, unsigned char* smem, int j) {
    const int tid = otid(), w = tid >> 6, lane = tid & 63, fr = lane & 15, fq = lane >> 4;
    const bf16_t* Memb = (const bf16_t*)(p.ws + O_MEMB); const bf16_t* Wm = (const bf16_t*)(p.ws + O_WMKV);
    bf16_t* MKb = (bf16_t*)(p.ws + O_MKB); bf16_t* MVT = (bf16_t*)(p.ws + O_MVT);
    const int rb = j >> 5, cb = j & 31, col0 = 64 * cb, arow0 = 64 * rb;
    f32x4 acc[4][4]; sk_zero(acc);
    const bf16_t* ap = Memb + (size_t)(arow0 + fr) * D + 8 * fq; const bf16_t* bp = Wm + (size_t)(col0 + fr) * D + 8 * fq;
    float* out = p.out;
    if (col0 < 1024) {
        sk_mma<4, 4, false, 2>(acc, ap, (size_t)16 * D, bp, (size_t)16 * D, 8 * w, 8 * w + 8);
        sk_reduce<16>(smem, &acc[0][0], [&](int, int t, int ln, f32x4 v) { const int rt = t >> 2, ct = t & 3, r = ln & 15, q = ln >> 4;
            const int row = arow0 + 16 * rt + r, col = col0 + 16 * ct + 4 * q;
            *(f32x4*)(out + OUT_PMK + (size_t)row * 1024 + col) = v;
            u32x2 o; o.x = pk2(v[0], v[1]); o.y = pk2(v[2], v[3]); *(u32x2*)(MKb + (size_t)row * 1024 + col) = o; });
    } else {
        sk_mma<4, 4, true, 2>(acc, ap, (size_t)16 * D, bp, (size_t)16 * D, 8 * w, 8 * w + 8);
        sk_reduce<16>(smem, &acc[0][0], [&](int, int t, int ln, f32x4 v) { const int rt = t >> 2, ct = t & 3, r = ln & 15, q = ln >> 4;
            const int row = arow0 + 16 * rt + 4 * q, c = col0 - 1024 + 16 * ct + r, b = row >> 8, mloc = row & 255;
#pragma unroll
            for (int e = 0; e < 4; ++e) out[OUT_PMV + (size_t)(row + e) * 1024 + c] = v[e];
            u32x2 o; o.x = pk2(v[0], v[1]); o.y = pk2(v[2], v[3]); *(u32x2*)(MVT + ((size_t)b * 1024 + c) * 256 + mloc) = o; });
    }
}
__device__ __forceinline__ void p1_alr(const Params& p, unsigned char* smem, int j2) {
    const int tid = otid(), w = tid >> 6, lane = tid & 63, fr = lane & 15, fq = lane >> 4;
    const int j = j2 >> 1, half = j2 & 1;
    const bf16_t* Xb = (const bf16_t*)(p.ws + O_XB); const bf16_t* Walr = (const bf16_t*)(p.ws + O_WALR); float* BC = (float*)(p.ws + O_BC);
    float* alr = (float*)(smem + 32768);
    const int k = half * 512 + tid;
    float w2[16];
#pragma unroll
    for (int r = 0; r < 16; ++r) w2[r] = p.in[9][r * 1024 + k];
    const float bb = p.in[10][k];
    { f32x4 acc[4][1]; sk_zero(acc);
      sk_mma<4, 1, false, 4>(acc, Xb + (size_t)(64 * j + fr) * D + 8 * fq, (size_t)16 * D, Walr + (size_t)fr * D + 8 * fq, 0, 8 * w, 8 * w + 8);
      sk_reduce<4>(smem, &acc[0][0], [&](int, int t, int ln, f32x4 v) { *(f32x4*)(alr + (16 * t + (ln & 15)) * 16 + 4 * (ln >> 4)) = v; }); }
    const bool prompt = (64 * j) < NP;
    float run = 0.f;
    float* bcp = BC + (size_t)(64 * j) * 1024 + k;
#pragma unroll 4
    for (int t = 0; t < 64; ++t) { float z = bb;
#pragma unroll
        for (int r4 = 0; r4 < 4; ++r4) { const f32x4 a = *(const f32x4*)(alr + t * 16 + 4 * r4); z += a[0] * w2[4 * r4] + a[1] * w2[4 * r4 + 1] + a[2] * w2[4 * r4 + 2] + a[3] * w2[4 * r4 + 3]; }
        const float la = (fminf(z, 0.f) - __logf(1.0f + __expf(-fabsf(z)))) * 0.0625f;
        run = prompt ? run + la : la;
        bcp[(size_t)t * 1024] = run; }
    __syncthreads();
}

constexpr int QS = 264, TS = 72;
__device__ __forceinline__ void gla_prompt_job(const Params& p, unsigned char* smem, int g) {
    const int tid = otid(), w = tid >> 6, lane = tid & 63, fr = lane & 15, fq = lane >> 4;
    const int b = g >> 5, h = (g >> 3) & 3, j = g & 7;
    const bf16_t* P = (const bf16_t*)(p.ws + O_P); const float* BC = (const float*)(p.ws + O_BC); bf16_t* OG = (bf16_t*)(p.ws + O_OG);
    bf16_t* Qt = (bf16_t*)smem; bf16_t* Kt = Qt + 64 * QS; bf16_t* ST = Kt + 64 * QS; bf16_t* KtT = ST + 64 * QS; bf16_t* VT = KtT + 256 * TS; bf16_t* Pm = VT + 64 * TS;
    float* Dk = (float*)(Pm + 64 * TS);
    for (int i = tid; i < 64 * QS / 8; i += 512) ((u32x4*)ST)[i] = (u32x4){0u, 0u, 0u, 0u};
    f32x4 sacc[2][4];
#pragma unroll
    for (int a = 0; a < 2; ++a)
#pragma unroll
        for (int c = 0; c < 4; ++c) sacc[a][c] = (f32x4){0.f, 0.f, 0.f, 0.f};
    const size_t R0 = (size_t)b * 2048;
    u32x4 pq[4], pk[4], pv; f32x4 pb0[4], pb1[4]; float pd = 0.f;
#define GLA_PREFETCH(RB) do { const size_t rb_ = (RB); \
        _Pragma("unroll") for (int i = 0; i < 4; ++i) { const int s = tid + 512 * i, t = s >> 5, ks = s & 31; \
            const bf16_t* prow = P + (rb_ + t) * LDP + h * 256 + 8 * ks; pq[i] = *(const u32x4*)(prow + Q_OFF); pk[i] = *(const u32x4*)(prow + K_OFF); \
            const float* bcp = BC + (rb_ + t) * 1024 + h * 256 + 8 * ks; pb0[i] = *(const f32x4*)bcp; pb1[i] = *(const f32x4*)(bcp + 4); } \
        pv = *(const u32x4*)(P + (rb_ + (tid >> 3)) * LDP + V_OFF + h * 512 + j * 64 + 8 * (tid & 7)); \
        if (tid < 256) pd = BC[(rb_ + 63) * 1024 + h * 256 + tid]; } while (0)
    GLA_PREFETCH(R0);
    for (int n = 0; n < 32; ++n) {
        const size_t r0 = R0 + 64 * n;
#pragma unroll
        for (int i = 0; i < 4; ++i) { const int s = tid + 512 * i, t = s >> 5, ks = s & 31;
            float qf[8], kf[8]; unpack8(pq[i], qf); unpack8(pk[i], kf);
#pragma unroll
            for (int e = 0; e < 8; ++e) { const float bc = e < 4 ? pb0[i][e & 3] : pb1[i][e & 3]; qf[e] *= __expf(bc); kf[e] *= __expf(-bc); }
            *(u32x4*)(Qt + t * QS + 8 * ks) = pack8(qf); *(u32x4*)(Kt + t * QS + 8 * ks) = pack8(kf); }
        { const int t = tid >> 3, vs = tid & 7; const u32x4 v8 = pv;
            bf16_t* vp = VT + (8 * vs) * TS + t;
            vp[0 * TS] = (bf16_t)(v8.x & 0xffffu); vp[1 * TS] = (bf16_t)(v8.x >> 16); vp[2 * TS] = (bf16_t)(v8.y & 0xffffu); vp[3 * TS] = (bf16_t)(v8.y >> 16);
            vp[4 * TS] = (bf16_t)(v8.z & 0xffffu); vp[5 * TS] = (bf16_t)(v8.z >> 16); vp[6 * TS] = (bf16_t)(v8.w & 0xffffu); vp[7 * TS] = (bf16_t)(v8.w >> 16); }
        if (tid < 256) Dk[tid] = __expf(pd);
        if (n + 1 < 32) GLA_PREFETCH(r0 + 64);
        __syncthreads();
#pragma unroll
        for (int i = 0; i < 4; ++i) { const int s = tid + 512 * i, t = s & 63, ks = s >> 6;
            const u32x4 k8 = *(const u32x4*)(Kt + t * QS + 8 * ks);
            bf16_t* kp = KtT + (8 * ks) * TS + t;
            kp[0 * TS] = (bf16_t)(k8.x & 0xffffu); kp[1 * TS] = (bf16_t)(k8.x >> 16); kp[2 * TS] = (bf16_t)(k8.y & 0xffffu); kp[3 * TS] = (bf16_t)(k8.y >> 16);
            kp[4 * TS] = (bf16_t)(k8.z & 0xffffu); kp[5 * TS] = (bf16_t)(k8.z >> 16); kp[6 * TS] = (bf16_t)(k8.w & 0xffffu); kp[7 * TS] = (bf16_t)(k8.w >> 16); }
#pragma unroll
        for (int i = 0; i < 2; ++i) { const int T = 2 * w + i, tt = T >> 2, st = T & 3;
            f32x4 a = (f32x4){0.f, 0.f, 0.f, 0.f};
            if (st <= tt) {
#pragma unroll
                for (int ks = 0; ks < 8; ++ks) a = mfma16(ld8(Kt + (16 * st + fr) * QS + 32 * ks + 8 * fq), ld8(Qt + (16 * tt + fr) * QS + 32 * ks + 8 * fq), a); }
            const int tl = 16 * tt + fr, sl = 16 * st + 4 * fq;
#pragma unroll
            for (int r = 0; r < 4; ++r) if (sl + r > tl) a[r] = 0.f;
            u32x2 o; o.x = pk2(a[0], a[1]); o.y = pk2(a[2], a[3]); *(u32x2*)(Pm + tl * TS + sl) = o; }
        __syncthreads();
#pragma unroll
        for (int i = 0; i < 2; ++i) { const int T = 2 * w + i, tt = T >> 2, vt = T & 3;
            f32x4 a = (f32x4){0.f, 0.f, 0.f, 0.f};
#pragma unroll
            for (int ks = 0; ks < 2; ++ks) a = mfma16(ld8(VT + (16 * vt + fr) * TS + 32 * ks + 8 * fq), ld8(Pm + (16 * tt + fr) * TS + 32 * ks + 8 * fq), a);
#pragma unroll
            for (int ks = 0; ks < 8; ++ks) a = mfma16(ld8(ST + (16 * vt + fr) * QS + 32 * ks + 8 * fq), ld8(Qt + (16 * tt + fr) * QS + 32 * ks + 8 * fq), a);
            u32x2 ow; ow.x = pk2(a[0], a[1]); ow.y = pk2(a[2], a[3]); *(u32x2*)(OG + (r0 + 16 * tt + fr) * D + h * 512 + j * 64 + 16 * vt + 4 * fq) = ow; }
        __syncthreads();
#pragma unroll
        for (int k2 = 0; k2 < 2; ++k2) { const int kt = 2 * w + k2;
            const bf16x8 X0 = ld8(KtT + (16 * kt + fr) * TS + 8 * fq), X1 = ld8(KtT + (16 * kt + fr) * TS + 32 + 8 * fq);
            const f32x4 dk = *(const f32x4*)(Dk + 16 * kt + 4 * fq);
#pragma unroll
            for (int vt = 0; vt < 4; ++vt) { f32x4 a = sacc[k2][vt];
                a = mfma16(X0, ld8(VT + (16 * vt + fr) * TS + 8 * fq), a); a = mfma16(X1, ld8(VT + (16 * vt + fr) * TS + 32 + 8 * fq), a);
                a = a * dk; sacc[k2][vt] = a;
                u32x2 o; o.x = pk2(a[0], a[1]); o.y = pk2(a[2], a[3]); *(u32x2*)(ST + (16 * vt + fr) * QS + 16 * kt + 4 * fq) = o; } }
        __syncthreads();
    }
#undef GLA_PREFETCH
    float* so = p.out + OUT_PGLA + ((size_t)(b * 4 + h) * 256) * 512 + j * 64;
#pragma unroll
    for (int k2 = 0; k2 < 2; ++k2)
#pragma unroll
        for (int vt = 0; vt < 4; ++vt)
#pragma unroll
            for (int r = 0; r < 4; ++r) so[(size_t)(16 * (2 * w + k2) + 4 * fq + r) * 512 + 16 * vt + fr] = sacc[k2][vt][r];
}

__device__ __forceinline__ void gla_sample_job(const Params& p, unsigned char* smem, int jb) {
    const int tid = otid(); const int b = jb >> 2, h = jb & 3;
    const bf16_t* P = (const bf16_t*)(p.ws + O_P); const float* BC = (const float*)(p.ws + O_BC); bf16_t* OG = (bf16_t*)(p.ws + O_OG);
    float* sq = (float*)smem; float* sk = sq + 256; float* sa = sk + 256; float* red = sa + 256;
    const size_t row = (size_t)NP + b;
    if (tid < 256) { const bf16_t* prow = P + row * LDP + h * 256 + tid; sq[tid] = bf2f(prow[Q_OFF]); sk[tid] = bf2f(prow[K_OFF]); sa[tid] = __expf(BC[row * 1024 + h * 256 + tid]); }
    const int v4 = tid & 127, kg = tid >> 7;
    const u32x2 vv = *(const u32x2*)(P + row * LDP + V_OFF + h * 512 + 4 * v4);
    f32x4 v; v[0] = bflo(vv.x); v[1] = bfhi(vv.x); v[2] = bflo(vv.y); v[3] = bfhi(vv.y);
    const f32x4* Sin = (const f32x4*)(p.in[5] + ((size_t)(b * 4 + h) * 256 + kg * 64) * 512) + v4;
    f32x4* Sout = (f32x4*)(p.out + OUT_SGLA + ((size_t)(b * 4 + h) * 256 + kg * 64) * 512) + v4;
    f32x4 s0[16];
#pragma unroll
    for (int i = 0; i < 16; ++i) s0[i] = __builtin_nontemporal_load(Sin + (size_t)i * 128);
    __syncthreads();
    f32x4 o = (f32x4){0.f, 0.f, 0.f, 0.f};
    for (int k0 = 0; k0 < 64; k0 += 16) {
        f32x4 s[16];
#pragma unroll
        for (int i = 0; i < 16; ++i) s[i] = s0[i];
        if (k0 + 16 < 64) {
#pragma unroll
            for (int i = 0; i < 16; ++i) s0[i] = __builtin_nontemporal_load(Sin + (size_t)(k0 + 16 + i) * 128); }
#pragma unroll
        for (int i = 0; i < 16; ++i) { const int k = kg * 64 + k0 + i;
            s[i] = s[i] * sa[k] + v * sk[k];
            __builtin_nontemporal_store(s[i], Sout + (size_t)(k0 + i) * 128);
            o = o + s[i] * sq[k]; }
    }
    *(f32x4*)(red + kg * 512 + 4 * v4) = o;
    __syncthreads();
    if (tid < 128) { const f32x4 r = *(const f32x4*)(red + 4 * tid) + *(const f32x4*)(red + 512 + 4 * tid) + *(const f32x4*)(red + 1024 + 4 * tid) + *(const f32x4*)(red + 1536 + 4 * tid);
        u32x2 ow; ow.x = pk2(r[0], r[1]); ow.y = pk2(r[2], r[3]); *(u32x2*)(OG + row * D + h * 512 + 4 * tid) = ow; }
    __syncthreads();
}

__device__ __forceinline__ void attn_prompt_job(const Params& p, int j) {
    const int tid = otid(), w = tid >> 6, lane = tid & 63, fr = lane & 15, fq = lane >> 4;
    const int b = j >> 6, h = (j >> 4) & 3, qt = j & 15;
    const bf16_t* P = (const bf16_t*)(p.ws + O_P); const bf16_t* MKb = (const bf16_t*)(p.ws + O_MKB); const bf16_t* MVT = (const bf16_t*)(p.ws + O_MVT); bf16_t* Am = (bf16_t*)(p.ws + O_AM);
    const size_t row = (size_t)b * 2048 + qt * 128 + 16 * w + fr;
    const bf16_t* qp = P + row * LDP + MQ_OFF + h * 256 + 8 * fq;
    bf16x8 Yq[8];
#pragma unroll
    for (int ks = 0; ks < 8; ++ks) Yq[ks] = ld8(qp + 32 * ks);
    f32x4 lg[16];
    const bf16_t* kp = MKb + (size_t)(b * 256 + fr) * 1024 + h * 256 + 8 * fq;
#pragma unroll
    for (int m2 = 0; m2 < 8; ++m2) {
        bf16x8 kf[2][8];
#pragma unroll
        for (int t = 0; t < 2; ++t)
#pragma unroll
            for (int ks = 0; ks < 8; ++ks) kf[t][ks] = ld8(kp + (size_t)(2 * m2 + t) * 16 * 1024 + 32 * ks);
#pragma unroll
        for (int t = 0; t < 2; ++t) { f32x4 a = (f32x4){0.f, 0.f, 0.f, 0.f};
#pragma unroll
            for (int ks = 0; ks < 8; ++ks) a = mfma16(kf[t][ks], Yq[ks], a);
            lg[2 * m2 + t] = a; } }
    float mx = -3.0e38f;
#pragma unroll
    for (int mt = 0; mt < 16; ++mt) mx = fmaxf(fmaxf(fmaxf(lg[mt][0], lg[mt][1]), fmaxf(lg[mt][2], lg[mt][3])), mx);
    mx = fmaxf(mx, __shfl_xor(mx, 16)); mx = fmaxf(mx, __shfl_xor(mx, 32));
    float sum = 0.f;
    bf16x8 Yp[8];
#pragma unroll
    for (int i = 0; i < 8; ++i) { u32x4 wv; f32x4 e0, e1;
#pragma unroll
        for (int r = 0; r < 4; ++r) { e0[r] = __expf(lg[2 * i][r] - mx); e1[r] = __expf(lg[2 * i + 1][r] - mx); }
        sum += (e0[0] + e0[1]) + (e0[2] + e0[3]) + (e1[0] + e1[1]) + (e1[2] + e1[3]);
        wv.x = pk2(e0[0], e0[1]); wv.y = pk2(e0[2], e0[3]); wv.z = pk2(e1[0], e1[1]); wv.w = pk2(e1[2], e1[3]);
        Yp[i] = __builtin_bit_cast(bf16x8, wv); }
    sum += __shfl_xor(sum, 16); sum += __shfl_xor(sum, 32);
    const float inv = 1.0f / sum;
    const bf16_t* vp = MVT + ((size_t)b * 1024 + h * 256 + fr) * 256 + 4 * fq;
    bf16_t* op = Am + row * 1024 + h * 256 + 4 * fq;
    u32x2 vf[2][2][8][2];
#pragma unroll
    for (int t = 0; t < 2; ++t)
#pragma unroll
        for (int i = 0; i < 8; ++i) { vf[0][t][i][0] = *(const u32x2*)(vp + (size_t)t * 16 * 256 + 32 * i); vf[0][t][i][1] = *(const u32x2*)(vp + (size_t)t * 16 * 256 + 32 * i + 16); }
#pragma unroll
    for (int d2 = 0; d2 < 8; ++d2) {
        if (d2 + 1 < 8) {
#pragma unroll
            for (int t = 0; t < 2; ++t)
#pragma unroll
                for (int i = 0; i < 8; ++i) { const bf16_t* q = vp + (size_t)(2 * (d2 + 1) + t) * 16 * 256 + 32 * i;
                    vf[(d2 + 1) & 1][t][i][0] = *(const u32x2*)q; vf[(d2 + 1) & 1][t][i][1] = *(const u32x2*)(q + 16); } }
#pragma unroll
        for (int t = 0; t < 2; ++t) { f32x4 a = (f32x4){0.f, 0.f, 0.f, 0.f};
#pragma unroll
            for (int i = 0; i < 8; ++i) { u32x4 xv; xv.x = vf[d2 & 1][t][i][0].x; xv.y = vf[d2 & 1][t][i][0].y; xv.z = vf[d2 & 1][t][i][1].x; xv.w = vf[d2 & 1][t][i][1].y;
                a = mfma16(__builtin_bit_cast(bf16x8, xv), Yp[i], a); }
            a = a * inv; u32x2 o; o.x = pk2(a[0], a[1]); o.y = pk2(a[2], a[3]); *(u32x2*)(op + 16 * (2 * d2 + t)) = o; } }
}

__device__ __forceinline__ void attn_sample_job(const Params& p, unsigned char* smem, int b) {
    const int tid = otid(), w = tid >> 6, lane = tid & 63;
    const bf16_t* P = (const bf16_t*)(p.ws + O_P); bf16_t* Am = (bf16_t*)(p.ws + O_AM);
    float* sq = (float*)smem; float* lg = sq + 1024; f32x4* red = (f32x4*)(smem + 8192);
    for (int i = tid; i < 1024; i += 512) sq[i] = bf2f(P[(size_t)(NP + b) * LDP + MQ_OFF + i]);
    const f32x4* kc = (const f32x4*)(p.in[3] + (size_t)b * 256 * 1024) + (size_t)w * 128 * 64 + lane;
    f32x4 k0[8];
#pragma unroll
    for (int i = 0; i < 8; ++i) k0[i] = __builtin_nontemporal_load(kc + (size_t)i * 64);
    __syncthreads();
    for (int r0 = 0; r0 < 128; r0 += 8) {
        f32x4 kv[8];
#pragma unroll
        for (int i = 0; i < 8; ++i) kv[i] = k0[i];
        if (r0 + 8 < 128) {
#pragma unroll
            for (int i = 0; i < 8; ++i) k0[i] = __builtin_nontemporal_load(kc + (size_t)(r0 + 8 + i) * 64); }
#pragma unroll
        for (int i = 0; i < 8; ++i) { const int rho = w * 128 + r0 + i, hh = rho & 3;
            const f32x4 qv = *(const f32x4*)(sq + hh * 256 + 4 * lane);
            float d = kv[i][0] * qv[0] + kv[i][1] * qv[1] + kv[i][2] * qv[2] + kv[i][3] * qv[3];
            d = wave_sum(d);
            if (lane == 0) lg[hh * 256 + (rho >> 2)] = d; }
    }
    __syncthreads();
    if (w < 4) { float l[4]; float mx = -3.0e38f;
#pragma unroll
        for (int i = 0; i < 4; ++i) { l[i] = lg[w * 256 + lane + 64 * i]; mx = fmaxf(mx, l[i]); }
        for (int o = 32; o >= 1; o >>= 1) mx = fmaxf(mx, __shfl_xor(mx, o));
        float sm = 0.f;
#pragma unroll
        for (int i = 0; i < 4; ++i) { l[i] = __expf(l[i] - mx); sm += l[i]; }
        sm = wave_sum(sm); const float inv = 1.0f / sm;
#pragma unroll
        for (int i = 0; i < 4; ++i) lg[w * 256 + lane + 64 * i] = l[i] * inv; }
    const int c4 = tid & 255, mh = tid >> 8, hh = c4 >> 6;
    const f32x4* vc = (const f32x4*)(p.in[4] + (size_t)b * 256 * 1024) + (size_t)mh * 128 * 256 + c4;
    f32x4 v0[16];
#pragma unroll
    for (int i = 0; i < 16; ++i) v0[i] = __builtin_nontemporal_load(vc + (size_t)i * 256);
    __syncthreads();
    f32x4 a = (f32x4){0.f, 0.f, 0.f, 0.f};
    for (int m0 = 0; m0 < 128; m0 += 16) {
        f32x4 vv[16];
#pragma unroll
        for (int i = 0; i < 16; ++i) vv[i] = v0[i];
        if (m0 + 16 < 128) {
#pragma unroll
            for (int i = 0; i < 16; ++i) v0[i] = __builtin_nontemporal_load(vc + (size_t)(m0 + 16 + i) * 256); }
#pragma unroll
        for (int i = 0; i < 16; ++i) a = a + vv[i] * lg[hh * 256 + mh * 128 + m0 + i];
    }
    red[mh * 256 + c4] = a;
    __syncthreads();
    if (tid < 256) { const f32x4 r = red[tid] + red[256 + tid]; u32x2 o; o.x = pk2(r[0], r[1]); o.y = pk2(r[2], r[3]);
        *(u32x2*)(Am + (size_t)(NP + b) * 1024 + 4 * tid) = o; }
    __syncthreads();
}

__device__ __forceinline__ void conv_job(const Params& p, int jc) {
    const int tid = otid(), seg = tid & 127, run = tid >> 7, c = 8 * seg;
    const bf16_t* P = (const bf16_t*)(p.ws + O_P); bf16_t* Ab = (bf16_t*)(p.ws + O_AB);
    const float* wc = p.in[13];
    float w0[8], w1[8], w2[8];
    { const f32x4 a0 = *(const f32x4*)(wc + c), a1 = *(const f32x4*)(wc + c + 4), b0 = *(const f32x4*)(wc + 1024 + c), b1 = *(const f32x4*)(wc + 1024 + c + 4), c0 = *(const f32x4*)(wc + 2048 + c), c1 = *(const f32x4*)(wc + 2048 + c + 4);
#pragma unroll
      for (int e = 0; e < 4; ++e) { w0[e] = a0[e]; w0[4 + e] = a1[e]; w1[e] = b0[e]; w1[4 + e] = b1[e]; w2[e] = c0[e]; w2[4 + e] = c1[e]; } }
    const int rowb = 128 * jc + 32 * run;
    const bf16_t* pb = P + (size_t)rowb * LDP + c;
    if (rowb < NP) {
        const int t0 = rowb & 2047, b = rowb >> 11;
        float u0[8], u1[8];
#pragma unroll
        for (int e = 0; e < 8; ++e) { u0[e] = 0.f; u1[e] = 0.f; }
        if (t0 >= 2) { float a[8], bq[8];
            unpack8(*(const u32x4*)(pb - 2 * LDP + CC_OFF), a); unpack8(*(const u32x4*)(pb - 2 * LDP + CH_OFF), bq);
#pragma unroll
            for (int e = 0; e < 8; ++e) u0[e] = a[e] * bq[e];
            unpack8(*(const u32x4*)(pb - LDP + CC_OFF), a); unpack8(*(const u32x4*)(pb - LDP + CH_OFF), bq);
#pragma unroll
            for (int e = 0; e < 8; ++e) u1[e] = a[e] * bq[e]; }
        for (int r0 = 0; r0 < 32; r0 += 4) {
            u32x4 xc[4], xh[4], xb[4];
#pragma unroll
            for (int i = 0; i < 4; ++i) { const bf16_t* pr = pb + (size_t)(r0 + i) * LDP; xc[i] = *(const u32x4*)(pr + CC_OFF); xh[i] = *(const u32x4*)(pr + CH_OFF); xb[i] = *(const u32x4*)(pr + CB_OFF); }
#pragma unroll
            for (int i = 0; i < 4; ++i) { float a[8], bq[8], cb[8], u2[8], y[8];
                unpack8(xc[i], a); unpack8(xh[i], bq); unpack8(xb[i], cb);
#pragma unroll
                for (int e = 0; e < 8; ++e) { u2[e] = a[e] * bq[e]; y[e] = cb[e] * (w0[e] * u0[e] + w1[e] * u1[e] + w2[e] * u2[e]); u0[e] = u1[e]; u1[e] = u2[e]; }
                *(u32x4*)(Ab + (size_t)(rowb + r0 + i) * 1024 + c) = pack8(y);
                const int t = t0 + r0 + i;
                if (t >= 2046) { float* so = p.out + OUT_PCONV + (size_t)(b * 2 + (t - 2046)) * 1024 + c;
#pragma unroll
                    for (int e = 0; e < 8; ++e) so[e] = u2[e]; } }
        }
    } else {
        for (int r0 = 0; r0 < 32; r0 += 4) {
            u32x4 xc[4], xh[4], xb[4]; f32x4 st[4][4];
#pragma unroll
            for (int i = 0; i < 4; ++i) { const bf16_t* pr = pb + (size_t)(r0 + i) * LDP; xc[i] = *(const u32x4*)(pr + CC_OFF); xh[i] = *(const u32x4*)(pr + CH_OFF); xb[i] = *(const u32x4*)(pr + CB_OFF);
                const float* sc = p.in[6] + (size_t)(rowb - NP + r0 + i) * 2048 + c;
                st[i][0] = *(const f32x4*)sc; st[i][1] = *(const f32x4*)(sc + 4); st[i][2] = *(const f32x4*)(sc + 1024); st[i][3] = *(const f32x4*)(sc + 1028); }
#pragma unroll
            for (int i = 0; i < 4; ++i) { float a[8], bq[8], cb[8], y[8]; f32x4 un0, un1;
                unpack8(xc[i], a); unpack8(xh[i], bq); unpack8(xb[i], cb);
#pragma unroll
                for (int e = 0; e < 8; ++e) { const float u0 = e < 4 ? st[i][0][e & 3] : st[i][1][e & 3], u1 = e < 4 ? st[i][2][e & 3] : st[i][3][e & 3], u2 = a[e] * bq[e];
                    y[e] = cb[e] * (w0[e] * u0 + w1[e] * u1 + w2[e] * u2); if (e < 4) un0[e & 3] = u2; else un1[e & 3] = u2; }
                const size_t bs = (size_t)(rowb - NP + r0 + i);
                *(u32x4*)(Ab + (size_t)(rowb + r0 + i) * 1024 + c) = pack8(y);
                float* so = p.out + OUT_SCONV + bs * 2048 + c;
                *(f32x4*)so = st[i][2]; *(f32x4*)(so + 4) = st[i][3]; *(f32x4*)(so + 1024) = un0; *(f32x4*)(so + 1028) = un1; }
        }
    }
}

__device__ __forceinline__ void phase_gla_norm(const Params& p) {
    const int tid = otid(), w = tid >> 6, lane = tid & 63;
    const bf16_t* P = (const bf16_t*)(p.ws + O_P); const bf16_t* OG = (const bf16_t*)(p.ws + O_OG); bf16_t* Aa = (bf16_t*)(p.ws + O_AA);
    const f32x4 g0 = *(const f32x4*)(p.in[11] + 8 * lane), g1 = *(const f32x4*)(p.in[11] + 8 * lane + 4);
    for (int row = blockIdx.x * 8 + w; row < NR; row += gridDim.x * 8) {
        f32x4 a[4], b[4]; u32x4 sgw[4];
#pragma unroll
        for (int h = 0; h < 4; ++h) { const u32x4 ow = *(const u32x4*)(OG + (size_t)row * D + h * 512 + 8 * lane);
            a[h][0] = bflo(ow.x); a[h][1] = bfhi(ow.x); a[h][2] = bflo(ow.y); a[h][3] = bfhi(ow.y); b[h][0] = bflo(ow.z); b[h][1] = bfhi(ow.z); b[h][2] = bflo(ow.w); b[h][3] = bfhi(ow.w);
            sgw[h] = *(const u32x4*)(P + (size_t)row * LDP + G_OFF + h * 512 + 8 * lane); }
#pragma unroll
        for (int h = 0; h < 4; ++h) {
            float ss = a[h][0] * a[h][0] + a[h][1] * a[h][1] + a[h][2] * a[h][2] + a[h][3] * a[h][3] + b[h][0] * b[h][0] + b[h][1] * b[h][1] + b[h][2] * b[h][2] + b[h][3] * b[h][3];
            ss = wave_sum(ss); const float rstd = rsqrtf(ss * (1.0f / 512.0f) + 1e-6f);
            float sg[8]; unpack8(sgw[h], sg);
            float y[8];
#pragma unroll
            for (int e = 0; e < 4; ++e) { y[e] = a[h][e] * rstd * g0[e] * sg[e]; y[4 + e] = b[h][e] * rstd * g1[e] * sg[4 + e]; }
            *(u32x4*)(Aa + (size_t)row * D + h * 512 + 8 * lane) = pack8(y); } }
}
template <bool FINAL>
__device__ __forceinline__ void phase_ln(const Params& p, const bf16_t* H, const float* gam, const float* bet) {
    const int tid = otid(), w = tid >> 6, lane = tid & 63;
    bf16_t* X1b = (bf16_t*)(p.ws + O_X1B);
    for (int row = blockIdx.x * 8 + w; row < NR; row += gridDim.x * 8) {
        u32x4 hw[4];
#pragma unroll
        for (int i = 0; i < 4; ++i) hw[i] = *(const u32x4*)(H + (size_t)row * D + 8 * (lane + 64 * i));
        float v[4][8]; float s = 0.f;
#pragma unroll
        for (int i = 0; i < 4; ++i) { unpack8(hw[i], v[i]);
#pragma unroll
            for (int e = 0; e < 8; ++e) s += v[i][e]; }
        const float mu = wave_sum(s) * (1.0f / 2048.0f);
        float q = 0.f;
#pragma unroll
        for (int i = 0; i < 4; ++i)
#pragma unroll
            for (int e = 0; e < 8; ++e) { v[i][e] -= mu; q += v[i][e] * v[i][e]; }
        const float rstd = rsqrtf(wave_sum(q) * (1.0f / 2048.0f) + 1e-5f);
        float* orow = row < NP ? p.out + OUT_YP + (size_t)row * D : p.out + OUT_YS + (size_t)(row - NP) * D;
#pragma unroll
        for (int i = 0; i < 4; ++i) { const int c = 8 * (lane + 64 * i);
            const f32x4 g0 = *(const f32x4*)(gam + c), g1 = *(const f32x4*)(gam + c + 4), b0 = *(const f32x4*)(bet + c), b1 = *(const f32x4*)(bet + c + 4);
            float y[8];
#pragma unroll
            for (int e = 0; e < 4; ++e) { y[e] = v[i][e] * rstd * g0[e] + b0[e]; y[4 + e] = v[i][4 + e] * rstd * g1[e] + b1[e]; }
            if (FINAL) { *(f32x4*)(orow + c) = (f32x4){y[0], y[1], y[2], y[3]}; *(f32x4*)(orow + c + 4) = (f32x4){y[4], y[5], y[6], y[7]}; }
            else *(u32x4*)(X1b + (size_t)row * D + c) = pack8(y); } }
}
__device__ __forceinline__ void phase_ffn_mid(const Params& p) {
    const bf16_t* HGU = (const bf16_t*)(p.ws + O_P); bf16_t* Af = (bf16_t*)(p.ws + O_OG);
    const float* wf = p.in[23]; const float* bf = p.in[24];
    const size_t stride = (size_t)gridDim.x * 512, t00 = (size_t)blockIdx.x * 512 + otid();
    for (size_t u = t00; u < (size_t)(NP / 16) * 688; u += stride) { const int rb = (int)(u / 688), seg = (int)(u - (size_t)rb * 688), c = 8 * seg, row0 = 16 * rb, t0 = row0 & 2047, b = row0 >> 11;
        float w0[8], w1[8], w2[8], bb[8];
        { const f32x4 a0 = *(const f32x4*)(wf + c), a1 = *(const f32x4*)(wf + c + 4), b0 = *(const f32x4*)(wf + DFF + c), b1 = *(const f32x4*)(wf + DFF + c + 4), c0 = *(const f32x4*)(wf + 2 * DFF + c), c1 = *(const f32x4*)(wf + 2 * DFF + c + 4), d0 = *(const f32x4*)(bf + c), d1 = *(const f32x4*)(bf + c + 4);
#pragma unroll
          for (int e = 0; e < 4; ++e) { w0[e] = a0[e]; w0[4 + e] = a1[e]; w1[e] = b0[e]; w1[4 + e] = b1[e]; w2[e] = c0[e]; w2[4 + e] = c1[e]; bb[e] = d0[e]; bb[4 + e] = d1[e]; } }
        const bf16_t* hb = HGU + (size_t)row0 * NGU + c;
        float h0[8], h1[8];
#pragma unroll
        for (int e = 0; e < 8; ++e) { h0[e] = 0.f; h1[e] = 0.f; }
        if (t0 >= 2) { unpack8(*(const u32x4*)(hb - 2 * NGU), h0); unpack8(*(const u32x4*)(hb - NGU), h1); }
        for (int r0 = 0; r0 < 16; r0 += 8) {
            u32x4 xg[8], xu[8];
#pragma unroll
            for (int i = 0; i < 8; ++i) { const bf16_t* hr = hb + (size_t)(r0 + i) * NGU; xg[i] = *(const u32x4*)hr; xu[i] = *(const u32x4*)(hr + DFF); }
#pragma unroll
            for (int i = 0; i < 8; ++i) { float h2[8], hu[8], y[8]; unpack8(xg[i], h2); unpack8(xu[i], hu);
#pragma unroll
                for (int e = 0; e < 8; ++e) { const float hc = w0[e] * h0[e] + w1[e] * h1[e] + w2[e] * h2[e] + bb[e]; y[e] = silu(hc) * hu[e]; h0[e] = h1[e]; h1[e] = h2[e]; }
                *(u32x4*)(Af + (size_t)(row0 + r0 + i) * DFF + c) = pack8(y);
                const int t = t0 + r0 + i;
                if (t >= 2046) { float* so = p.out + OUT_PFFN + (size_t)(b * 2 + (t - 2046)) * DFF + c;
#pragma unroll
                    for (int e = 0; e < 8; ++e) so[e] = h2[e]; } }
        }
    }
    for (size_t it = t00; it < (size_t)NS * 688; it += stride) { const int bs = (int)(it / 688), seg = (int)(it - (size_t)bs * 688), c = 8 * seg;
        const bf16_t* hrow = HGU + (size_t)(NP + bs) * NGU + c;
        float h0[8], h1[8], h2[8], hu[8], y[8];
        unpack8(*(const u32x4*)hrow, h2); unpack8(*(const u32x4*)(hrow + DFF), hu);
        const float* sc = p.in[7] + (size_t)bs * 2 * DFF + c; float* so = p.out + OUT_SFFN + (size_t)bs * 2 * DFF + c;
#pragma unroll
        for (int e = 0; e < 8; ++e) { h0[e] = sc[e]; h1[e] = sc[DFF + e]; so[e] = h1[e]; so[DFF + e] = h2[e]; }
#pragma unroll
        for (int e = 0; e < 8; ++e) { const float hc = wf[c + e] * h0[e] + wf[DFF + c + e] * h1[e] + wf[2 * DFF + c + e] * h2[e] + bf[c + e]; y[e] = silu(hc) * hu[e]; }
        *(u32x4*)(Af + (size_t)(NP + bs) * DFF + c) = pack8(y); }
}

__device__ __forceinline__ void samp_mma(f32x4 (&acc)[4][2], const bf16_t* A, int lda, const bf16_t* Bt, int K, int j) {
    const int tid = otid(), w = tid >> 6, lane = tid & 63, fr = lane & 15, fq = lane >> 4;
    const int KS = K / 32, cb = j >> 1, rh = j & 1;
    sk_zero(acc);
    sk_mma<4, 2, false, 4>(acc, A + (size_t)(NP + 64 * rh + fr) * lda + 8 * fq, (size_t)16 * lda, Bt + (size_t)(32 * cb + fr) * K + 8 * fq, (size_t)16 * K, (w * KS) >> 3, ((w + 1) * KS) >> 3);
}

__global__ __launch_bounds__(512, 2) void mega(Params p) {
    extern __shared__ __attribute__((aligned(16))) unsigned char shm[];
    cg::grid_group grid = cg::this_grid();
    PG8_LAS unsigned char* lds = (PG8_LAS unsigned char*)shm;
    unsigned char* ws = p.ws;
    const int G = gridDim.x, bid = blockIdx.x, tid = threadIdx.x;
    bf16_t* Xb = (bf16_t*)(ws + O_XB); bf16_t* P = (bf16_t*)(ws + O_P);
    pg8::StaticOrder S;
    volatile LAS unsigned* xst = (volatile LAS unsigned*)(shm + LDS_BYTES - 32);
    if (tid == 0) { xst[0] = 0u; xst[1] = 0u; }
    __syncthreads();
    const XcdBarrier xb = xcd_barrier_post((unsigned*)(ws + O_CTRL), xst);

    for (int rep = 0; rep < REP_P0; ++rep) phase_convert(p, shm);
    if (p.ws == nullptr) grid.sync();
    xcd_barrier(xb);

    { S.init(NP, NIN, G, bid, REP_P1); EpiInproj E{P};
      pg8::gemm_phase<EpiInproj, pg8::StaticOrder>(lds, pg8::Gemm{Xb, (const bf16_t*)(ws + O_WIN), NP, NIN, D}, S, E, nullptr); }
    __syncthreads();
    for (int rep = 0; rep < REP_SK; ++rep) {
    for (int j = bid; j < 512; j += G) p1_sample_inproj(p, shm, j);
    for (int j = bid; j < 512; j += G) p1_memkv(p, shm, j);
    for (int j = bid; j < 260; j += G) p1_alr(p, shm, j); }
    xcd_barrier(xb);

    for (int rep = 0; rep < REP_P2; ++rep)
    { int* sjob = (int*)(shm + LDS_BYTES - 64); unsigned* ctr = (unsigned*)(ws + O_CTRL) + 64 * rep;
      if (bid < 128) for (int r2 = 0; r2 < REP_GLA; ++r2) gla_prompt_job(p, shm, bid);
      for (;;) {
          __syncthreads();
          if (tid == 0) *sjob = (int)atomicAdd(ctr, 1u);
          __syncthreads();
          const int q = *sjob;
          if (q >= 961) break;
          int j;
          { const int t = q / 3, r = q - 3 * t; if (r == 2) j = 640 + t; else { j = 2 * t + r; if (j >= 640) j = 960; } }
          if (j < 512) gla_sample_job(p, shm, j);
          else if (j < 640) attn_sample_job(p, shm, j - 512);
          else if (j < 896) attn_prompt_job(p, j - 640);
          else conv_job(p, j - 896);
      } }
    xcd_barrier(xb);

    phase_gla_norm(p);
    xcd_barrier(xb);

    { float* MGf = (float*)(ws + O_MGF); bf16_t* MGb = (bf16_t*)(ws + O_MGB);
      const bf16_t* Aa = (const bf16_t*)(ws + O_AA); const bf16_t* Ab = (const bf16_t*)(ws + O_AB); const bf16_t* Am = (const bf16_t*)(ws + O_AM);
      const bf16_t* Wgo = (const bf16_t*)(ws + O_WGO); const bf16_t* Wco = (const bf16_t*)(ws + O_WCO); const bf16_t* Wmo = (const bf16_t*)(ws + O_WMO);
      S.init(NP, D, G, bid);
      { EpiMerge E{P, MGf, MGb, ZA_OFF, 0}; pg8::gemm_phase<EpiMerge, pg8::StaticOrder>(lds, pg8::Gemm{Aa, Wgo, NP, D, D}, S, E, nullptr); }
      { EpiMerge E{P, MGf, MGb, ZB_OFF, 1}; pg8::gemm_phase<EpiMerge, pg8::StaticOrder>(lds, pg8::Gemm{Ab, Wco, NP, D, 1024}, S, E, nullptr); }
      { EpiMerge E{P, MGf, MGb, ZM_OFF, 2}; pg8::gemm_phase<EpiMerge, pg8::StaticOrder>(lds, pg8::Gemm{Am, Wmo, NP, D, 1024}, S, E, nullptr); }
      for (int rep = 0; rep < REP_SK; ++rep)
      for (int j = bid; j < 128; j += G) { const int cb = j >> 1, rh = j & 1;
          f32x4 fin = (f32x4){0.f, 0.f, 0.f, 0.f};
#pragma unroll
          for (int br = 0; br < 3; ++br) { f32x4 acc[4][2];
              if (br == 0) samp_mma(acc, Aa, D, Wgo, D, j); else if (br == 1) samp_mma(acc, Ab, 1024, Wco, 1024, j); else samp_mma(acc, Am, 1024, Wmo, 1024, j);
              const int zoff = br == 0 ? ZA_OFF : br == 1 ? ZB_OFF : ZM_OFF;
              sk_reduce<8>(shm, &acc[0][0], [&](int, int t, int ln, f32x4 v) { const int rt = t >> 1, ct = t & 1, r = ln & 15, q = ln >> 4;
                  const u32x2 gw = *(const u32x2*)(P + (size_t)(NP + 64 * rh + 16 * rt + r) * LDP + zoff + 32 * cb + 16 * ct + 4 * q);
                  f32x4 g; g[0] = bflo(gw.x); g[1] = bfhi(gw.x); g[2] = bflo(gw.y); g[3] = bfhi(gw.y);
                  fin = fin + g * v; }); }
          { const int s2 = otid(), t = s2 >> 6, ln = s2 & 63, rt = t >> 1, ct = t & 1, r = ln & 15, q = ln >> 4;
              u32x2 o; o.x = pk2(fin[0], fin[1]); o.y = pk2(fin[2], fin[3]);
              *(u32x2*)(MGb + (size_t)(NP + 64 * rh + 16 * rt + r) * D + 32 * cb + 16 * ct + 4 * q) = o; } } }
    xcd_barrier(xb);

    { const bf16_t* MGb = (const bf16_t*)(ws + O_MGB); const bf16_t* Wo = (const bf16_t*)(ws + O_WO); bf16_t* H1 = (bf16_t*)(ws + O_H1);
      S.init(NP, D, G, bid);
      { EpiResidB E{Xb, H1}; pg8::gemm_phase<EpiResidB, pg8::StaticOrder>(lds, pg8::Gemm{MGb, Wo, NP, D, D}, S, E, nullptr); }
      for (int rep = 0; rep < REP_SK; ++rep)
      for (int j = bid; j < 128; j += G) { f32x4 acc[4][2]; samp_mma(acc, MGb, D, Wo, D, j); const float* xs = p.in[1]; const int cb = j >> 1, rh = j & 1;
          sk_reduce<8>(shm, &acc[0][0], [&](int, int t, int ln, f32x4 v) { const int rt = t >> 1, ct = t & 1, r = 64 * rh + 16 * rt + (ln & 15), col = 32 * cb + 16 * ct + 4 * (ln >> 4);
              const f32x4 y = *(const f32x4*)(xs + (size_t)r * D + col) * DN_ALPHA + v;
              u32x2 w; w.x = pk2(y[0], y[1]); w.y = pk2(y[2], y[3]); *(u32x2*)(H1 + (size_t)(NP + r) * D + col) = w; }); } }
    xcd_barrier(xb);

    phase_ln<false>(p, (const bf16_t*)(ws + O_H1), p.in[19], p.in[20]);
    xcd_barrier(xb);

    { S.init(NRP, NGU, G, bid, REP_P6); EpiBf16 E{P, NGU};
      pg8::gemm_phase<EpiBf16, pg8::StaticOrder>(lds, pg8::Gemm{(const bf16_t*)(ws + O_X1B), (const bf16_t*)(ws + O_WGU), NRP, NGU, D}, S, E, nullptr); }
    xcd_barrier(xb);

    for (int rep = 0; rep < REP_P7; ++rep) phase_ffn_mid(p);
    xcd_barrier(xb);

    { const bf16_t* Af = (const bf16_t*)(ws + O_OG); const bf16_t* Wd = (const bf16_t*)(ws + O_WD); const bf16_t* X1r = (const bf16_t*)(ws + O_X1B); bf16_t* H2 = (bf16_t*)(ws + O_H1);
      S.init(NP, D, G, bid);
      { EpiResidB E{X1r, H2}; pg8::gemm_phase<EpiResidB, pg8::StaticOrder>(lds, pg8::Gemm{Af, Wd, NP, D, DFF}, S, E, nullptr); }
      for (int rep = 0; rep < REP_SK; ++rep)
      for (int j = bid; j < 128; j += G) { f32x4 acc[4][2]; samp_mma(acc, Af, DFF, Wd, DFF, j); const int cb = j >> 1, rh = j & 1;
          sk_reduce<8>(shm, &acc[0][0], [&](int, int t, int ln, f32x4 v) { const int rt = t >> 1, ct = t & 1;
              const size_t o = (size_t)(NP + 64 * rh + 16 * rt + (ln & 15)) * D + 32 * cb + 16 * ct + 4 * (ln >> 4);
              const u32x2 rw = *(const u32x2*)(X1r + o); f32x4 r; r[0] = bflo(rw.x); r[1] = bfhi(rw.x); r[2] = bflo(rw.y); r[3] = bfhi(rw.y);
              const f32x4 y = r * DN_ALPHA + v; u32x2 w; w.x = pk2(y[0], y[1]); w.y = pk2(y[2], y[3]); *(u32x2*)(H2 + o) = w; }); } }
    xcd_barrier(xb);

    for (int rep = 1; rep < REP_SYNC; ++rep) xcd_barrier(xb);
    phase_ln<true>(p, (const bf16_t*)(ws + O_H1), p.in[26], p.in[27]);
}

extern "C" void kernel_launch(void* const* d_in, const int* in_sizes, int n_in, void* d_out, int out_size, void* d_ws, size_t ws_size, hipStream_t stream) {
    static int grid_blocks = 0;
    if (!grid_blocks) {
        int dev = 0, cus = 0, per_cu = 0;
        (void)hipGetDevice(&dev);
        (void)hipDeviceGetAttribute(&cus, hipDeviceAttributeMultiprocessorCount, dev);
        (void)hipFuncSetAttribute((const void*)mega, hipFuncAttributeMaxDynamicSharedMemorySize, LDS_BYTES);
        (void)hipOccupancyMaxActiveBlocksPerMultiprocessor(&per_cu, mega, 512, LDS_BYTES);
        if (per_cu > 1) per_cu = 1;
        grid_blocks = cus * per_cu;
        if (grid_blocks <= 0) { fprintf(stderr, "occupancy query returned 0 (cus %d per_cu %d)\n", cus, per_cu); grid_blocks = cus > 0 ? cus : 256; }
    }
    Params p; memset(&p, 0, sizeof(p));
    for (int i = 0; i < 28; ++i) p.in[i] = (const float*)d_in[i];
    p.out = (float*)d_out; p.ws = (unsigned char*)d_ws;
    unsigned char* ws = (unsigned char*)d_ws;
    (void)hipMemsetAsync(ws + O_CTRL, 0, 16384, stream);
    void* args[] = {&p};
    hipError_t e = hipLaunchCooperativeKernel((const void*)mega, dim3(grid_blocks), dim3(512), args, LDS_BYTES, stream);
    if (e != hipSuccess) fprintf(stderr, "cooperative launch failed: %s (grid %d)\n", hipGetErrorString(e), grid_blocks);
}
```

```cpp
#include <hip/hip_runtime.h>
#include <hip/hip_cooperative_groups.h>
#include <cstdio>
#include <cstring>
namespace cg = cooperative_groups;

namespace pg8 {
#define PG8_LAS __attribute__((address_space(3)))
typedef unsigned short bf16_t;
typedef short bf16x8 __attribute__((ext_vector_type(8)));
typedef float f32x4 __attribute__((ext_vector_type(4)));
typedef unsigned u32x4 __attribute__((ext_vector_type(4)));
typedef unsigned u32x2 __attribute__((ext_vector_type(2)));
constexpr int BM = 256, BK = 64, HALF = 128, HTB = HALF * BK * 2, STAGE_BYTES = 8 * HTB, NXCD = 8, WGM = 8;
__host__ __device__ __forceinline__ int lds_byte(int r, int c) { const int st = (r >> 4) * 2 + (c >> 5), rr = r & 15, cc = c & 31, ob = rr * 64 + cc * 2; return st * 1024 + (ob ^ (((ob >> 9) & 1) << 5)); }
__host__ __device__ __forceinline__ void stage_rc(int b, int& R, int& C) { const int st = b / 1024, sb = b % 1024, swz = sb ^ (((sb >> 9) & 1) << 5); R = (st >> 1) * 16 + swz / 64; C = (st & 1) * 32 + (swz % 64) / 2; }
__host__ __device__ __forceinline__ int perm32(int rho) { const int n = rho >> 4, i = rho & 15; return 8 * (i >> 2) + 4 * n + (i & 3); }
struct Unit { int pm, pn; };
struct Gemm { const bf16_t* A; const bf16_t* Bt; int M, N, K; };
struct StaticOrder {
    int nM, nN, nwg, G, c, reps;
    __host__ __device__ void init(int M, int N, int G_, int c_, int reps_ = 1) { nM = M / BM; nN = N / BM; nwg = nM * nN; G = G_; c = c_; reps = reps_; }
    __host__ __device__ bool next(int i, Unit& u) const {
        const long L = (long)i * G + c; if (L >= (long)nwg * reps) return false;
        int wgid = (int)(L % nwg); { const int q = nwg / NXCD, r = nwg % NXCD, xcd = wgid % NXCD, off = wgid / NXCD; wgid = (xcd < r ? xcd * (q + 1) : r * (q + 1) + (xcd - r) * q) + off; }
        const int nig = WGM * nN, gid = wgid / nig, fm = gid * WGM, gsz = (nM - fm) < WGM ? (nM - fm) : WGM;
        u.pm = fm + ((wgid % nig) % gsz); u.pn = (wgid % nig) / gsz; return true;
    }
    __device__ __forceinline__ void a_ready(const Unit&) const {}
    __device__ __forceinline__ void done(const Unit&) const {}
};
__device__ __forceinline__ unsigned cvt_pk_bf16(float lo, float hi) { unsigned r; asm volatile("v_cvt_pk_bf16_f32 %0, %1, %2" : "=v"(r) : "v"(lo), "v"(hi)); return r; }

template <class Epi, class Sched, bool STAMP = false>
__device__ __forceinline__ void gemm_phase(PG8_LAS unsigned char* lds, const Gemm g, const Sched& S, const Epi& E, unsigned long long* stamps) {
    const int tid = threadIdx.x, wid = __builtin_amdgcn_readfirstlane(tid >> 6), lane = tid & 63, wr = wid >> 2, wc = wid & 3, fr = lane & 15, fq = lane >> 4;
    const int K = g.K, nt = K / BK;
    int ts_lo = 0, ts_hi = 0, nts = 0; const unsigned long long rt_entry = STAMP ? (unsigned long long)wall_clock64() : 0ull;
#define PG8_STAMP() do { if (STAMP && wid == 0 && nts < 64) { const unsigned long long _c = (unsigned long long)clock64(); \
        ts_lo = (lane == nts) ? (int)(unsigned)_c : ts_lo; ts_hi = (lane == nts) ? (int)(unsigned)(_c >> 32) : ts_hi; ++nts; } } while (0)
    PG8_STAMP();
    unsigned voffA[2], voffB[2];
#pragma unroll
    for (int i = 0; i < 2; ++i) { int R, C; stage_rc(tid * 16 + i * 8192, R, C); const int Rb = Epi::PERM ? ((R & ~31) + perm32(R & 31)) : R;
        voffA[i] = (unsigned)(R * K + C) * 2u; voffB[i] = (unsigned)(Rb * K + C) * 2u; }
    const size_t kstep = (size_t)(BK * 2);
    const size_t hstep = (size_t)HALF * K * 2;
    const size_t tstep = 2 * hstep;
    const unsigned ldsw = (unsigned)wid * 1024u;
    const int aoff = lds_byte(wr * 64 + fr, fq * 8), boff = lds_byte(wc * 32 + fr, fq * 8);
#define PG8_SA(b, h) (((b) * 2 + (h)) * HTB)
#define PG8_SB(b, h) ((4 + (b) * 2 + (h)) * HTB)
#define PG8_STAGE(bufoff, gbase, voff) do { _Pragma("unroll") for (int _i = 0; _i < 2; ++_i) \
        __builtin_amdgcn_global_load_lds((const unsigned*)((const char*)(gbase) + (voff)[_i]), (PG8_LAS unsigned*)(lds + (bufoff) + ldsw + _i * 8192), 16, 0, 0); } while (0)
#define PG8_LDA(dst, b, h) do { _Pragma("unroll") for (int m = 0; m < 4; ++m) _Pragma("unroll") for (int k = 0; k < 2; ++k) dst[m][k] = *(const PG8_LAS bf16x8*)(lds + PG8_SA(b, h) + aoff + m * 2048 + k * 1024); } while (0)
#define PG8_LDB(dst, b, h) do { _Pragma("unroll") for (int n = 0; n < 2; ++n) _Pragma("unroll") for (int k = 0; k < 2; ++k) dst[n][k] = *(const PG8_LAS bf16x8*)(lds + PG8_SB(b, h) + boff + n * 2048 + k * 1024); } while (0)
#define PG8_MMA(ai, bj, At, Bt) do { __builtin_amdgcn_s_setprio(1); _Pragma("unroll") for (int m = 0; m < 4; ++m) _Pragma("unroll") for (int n = 0; n < 2; ++n) _Pragma("unroll") for (int k = 0; k < 2; ++k) \
        acc[ai][bj][m][n] = __builtin_amdgcn_mfma_f32_16x16x32_bf16(Bt[n][k], At[m][k], acc[ai][bj][m][n], 0, 0, 0); __builtin_amdgcn_s_setprio(0); } while (0)
#define PG8_WAIT_V(n) asm volatile("s_waitcnt vmcnt(" #n ")" ::: "memory")
#define PG8_WAIT_L(n) asm volatile("s_waitcnt lgkmcnt(" #n ")" ::: "memory")
#define PG8_BAR __builtin_amdgcn_s_barrier()
#define PG8_SCHED __builtin_amdgcn_sched_barrier(0)
    Unit cur, nxt; int ui = 0;
    if (!S.next(0, cur)) return;
    f32x4 acc[2][2][4][2];
#pragma unroll
    for (int a = 0; a < 2; ++a)
#pragma unroll
        for (int b = 0; b < 2; ++b)
#pragma unroll
            for (int m = 0; m < 4; ++m)
#pragma unroll
                for (int n = 0; n < 2; ++n) acc[a][b][m][n] = (f32x4){0.f, 0.f, 0.f, 0.f};
    bf16x8 At[4][2], B0[2][2], B1[2][2];
    const char* cA = (const char*)g.A + (size_t)cur.pm * tstep; const char* cB = (const char*)g.Bt + (size_t)cur.pn * tstep;
    S.a_ready(cur);
    PG8_STAGE(PG8_SB(0, 0), cB, voffB); PG8_STAGE(PG8_SA(0, 0), cA, voffA); PG8_STAGE(PG8_SB(0, 1), cB + hstep, voffB); PG8_STAGE(PG8_SA(0, 1), cA + hstep, voffA);
    if (wr == 1) PG8_BAR;
    PG8_WAIT_V(4); PG8_BAR;
    PG8_STAGE(PG8_SB(1, 0), cB + kstep, voffB); PG8_STAGE(PG8_SA(1, 0), cA + kstep, voffA); PG8_STAGE(PG8_SB(1, 1), cB + hstep + kstep, voffB);
    PG8_WAIT_V(6); PG8_BAR;
    PG8_STAMP();
    for (;;) {
        const bool has_next = S.next(ui + 1, nxt);
        const char* nA = has_next ? (const char*)g.A + (size_t)nxt.pm * tstep : cA; const char* nB = has_next ? (const char*)g.Bt + (size_t)nxt.pn * tstep : cB;
        for (int t = 0; t < nt; t += 2) {
            const bool last = (t == nt - 2);
            const char* a1 = cA + (size_t)(t + 1) * kstep;
            const char* a2 = last ? nA : cA + (size_t)(t + 2) * kstep; const char* b2 = last ? nB : cB + (size_t)(t + 2) * kstep;
            const char* a3 = a2 + kstep; const char* b3 = b2 + kstep;
            if (last && has_next) S.a_ready(nxt);
            PG8_LDB(B0, 0, 0); PG8_SCHED; PG8_LDA(At, 0, 0); PG8_STAGE(PG8_SA(1, 1), a1 + hstep, voffA);
            PG8_WAIT_L(8); PG8_BAR; PG8_WAIT_L(0); PG8_MMA(0, 0, At, B0); PG8_BAR; PG8_SCHED;
            PG8_LDB(B1, 0, 1); PG8_STAGE(PG8_SB(0, 0), b2, voffB);
            PG8_BAR; PG8_WAIT_L(0); PG8_MMA(0, 1, At, B1); PG8_BAR;
            PG8_LDA(At, 0, 1); PG8_STAGE(PG8_SA(0, 0), a2, voffA);
            PG8_BAR; PG8_WAIT_L(0); PG8_MMA(1, 0, At, B0); PG8_BAR; PG8_SCHED;
            PG8_STAGE(PG8_SB(0, 1), b2 + hstep, voffB);
            PG8_WAIT_V(6); PG8_BAR; PG8_MMA(1, 1, At, B1); PG8_BAR;
            PG8_LDB(B0, 1, 0); PG8_SCHED; PG8_LDA(At, 1, 0); PG8_STAGE(PG8_SA(0, 1), a2 + hstep, voffA);
            PG8_WAIT_L(8); PG8_BAR; PG8_WAIT_L(0); PG8_MMA(0, 0, At, B0); PG8_BAR; PG8_SCHED;
            PG8_LDB(B1, 1, 1); PG8_STAGE(PG8_SB(1, 0), b3, voffB);
            PG8_BAR; PG8_WAIT_L(0); PG8_MMA(0, 1, At, B1); PG8_BAR;
            PG8_LDA(At, 1, 1); PG8_STAGE(PG8_SA(1, 0), a3, voffA);
            PG8_BAR; PG8_WAIT_L(0); PG8_MMA(1, 0, At, B0); PG8_BAR; PG8_SCHED;
            PG8_STAGE(PG8_SB(1, 1), b3 + hstep, voffB);
            PG8_WAIT_V(6); PG8_BAR; PG8_MMA(1, 1, At, B1); PG8_BAR;
        }
        PG8_STAMP();
        if constexpr (!Epi::AFTER_DRAIN) { E(acc, cur, wr, wc, fr, fq); S.done(cur); }
        PG8_STAMP();
        if (!has_next) break;
#pragma unroll
        for (int a = 0; a < 2; ++a)
#pragma unroll
            for (int b = 0; b < 2; ++b)
#pragma unroll
                for (int m = 0; m < 4; ++m)
#pragma unroll
                    for (int n = 0; n < 2; ++n) acc[a][b][m][n] = (f32x4){0.f, 0.f, 0.f, 0.f};
        cur = nxt; cA = nA; cB = nB; ++ui;
    }
    PG8_WAIT_V(0);
    if (wr == 0) PG8_BAR;
    PG8_BAR;
    if constexpr (Epi::AFTER_DRAIN) { E.fused(acc, cur, wr, wc, fr, fq, lds, wid, lane); S.done(cur); }
    PG8_STAMP();
    if (STAMP && wid == 0) { stamps[lane] = lane < nts ? (((unsigned long long)(unsigned)ts_hi << 32) | (unsigned)ts_lo) : 0ull;
        if (lane == 62) stamps[62] = rt_entry; if (lane == 63) stamps[63] = (unsigned long long)wall_clock64(); }
#undef PG8_STAMP
#undef PG8_SA
#undef PG8_SB
#undef PG8_STAGE
#undef PG8_LDA
#undef PG8_LDB
#undef PG8_MMA
#undef PG8_WAIT_V
#undef PG8_WAIT_L
#undef PG8_BAR
#undef PG8_SCHED
}
}

using pg8::bf16_t; using pg8::bf16x8; using pg8::f32x4; using pg8::u32x4; using pg8::u32x2;

constexpr int D = 2048, NP = 8192, NS = 128, NR = 8320, NRP = 8448;
constexpr int NIN = 16384, LDP = 16384 + 64, WIN_LD = 16400;
constexpr int DFF = 5504, NGU = 11008;
constexpr int Q_OFF = 0, K_OFF = 1024, V_OFF = 2048, G_OFF = 4096, CB_OFF = 6144, CC_OFF = 7168, CH_OFF = 8192, MQ_OFF = 9216, ZA_OFF = 10240, ZB_OFF = 12288, ZM_OFF = 14336;
constexpr float DN_ALPHA = 1.189207115002721f;
constexpr int LDS_BYTES = 158 * 1024;
#ifndef PROBE
#define PROBE 0
#endif
constexpr int REP_P0 = (PROBE == 1) ? 2 : 1, REP_P2 = (PROBE == 2) ? 2 : 1, REP_SK = (PROBE == 3) ? 2 : 1, REP_P7 = (PROBE == 4) ? 2 : 1, REP_GLA = (PROBE == 5) ? 2 : 1, REP_P6 = (PROBE == 7) ? 2 : 1, REP_P1 = (PROBE == 8) ? 2 : 1, REP_SYNC = (PROBE == 9) ? 11 : 1;

constexpr size_t O_CTRL = 0;
constexpr size_t O_XB   = 32768;
constexpr size_t O_MEMB = O_XB + (size_t)NRP * D * 2;
constexpr size_t O_WIN  = O_MEMB + (size_t)1024 * D * 2;
constexpr size_t O_WALR = O_WIN + (size_t)NIN * D * 2;
constexpr size_t O_WGO  = O_WALR + (size_t)16 * D * 2;
constexpr size_t O_WCO  = O_WGO + (size_t)D * D * 2;
constexpr size_t O_WMO  = O_WCO + (size_t)D * 1024 * 2;
constexpr size_t O_WO   = O_WMO + (size_t)D * 1024 * 2;
constexpr size_t O_WMKV = O_WO + (size_t)D * D * 2;
constexpr size_t O_WGU  = O_WMKV + (size_t)D * D * 2;
constexpr size_t O_WD   = O_WGU + (size_t)NGU * D * 2;
constexpr size_t O_P    = O_WD + (size_t)D * DFF * 2;
constexpr size_t O_BC   = O_P + (size_t)NR * LDP * 2;
constexpr size_t O_MKB  = O_BC + (size_t)NR * 1024 * 4;
constexpr size_t O_MVT  = O_MKB + (size_t)1024 * 1024 * 2;
constexpr size_t O_OG   = O_MVT + (size_t)1024 * 1024 * 2;
constexpr size_t O_MGF  = O_OG + (size_t)NR * D * 4;
constexpr size_t O_AA   = O_MGF + (size_t)NP * D * 4;
constexpr size_t O_AB   = O_AA + (size_t)NR * D * 2;
constexpr size_t O_AM   = O_AB + (size_t)NR * 1024 * 2;
constexpr size_t O_MGB  = O_AM + (size_t)NR * 1024 * 2;
constexpr size_t O_H1   = O_MGB + (size_t)NR * D * 2;
constexpr size_t O_X1F  = O_H1 + (size_t)NR * D * 4;
constexpr size_t O_X1B  = O_X1F + (size_t)NR * D * 4;
constexpr size_t WS_TOTAL = O_X1B + (size_t)NRP * D * 2;
static_assert(WS_TOTAL <= (size_t)1073741824, "workspace too large");
static_assert((size_t)NRP * NGU * 2 <= (size_t)NR * LDP * 2, "HGU alias");
static_assert((size_t)NR * DFF * 2 <= (size_t)NR * D * 4 + (size_t)NP * D * 4, "A_ffn alias");

constexpr size_t OUT_YP = 0;
constexpr size_t OUT_YS = OUT_YP + (size_t)NP * D;
constexpr size_t OUT_PMK = OUT_YS + (size_t)NS * D;
constexpr size_t OUT_PMV = OUT_PMK + (size_t)1024 * 1024;
constexpr size_t OUT_PGLA = OUT_PMV + (size_t)1024 * 1024;
constexpr size_t OUT_PCONV = OUT_PGLA + (size_t)4 * 4 * 256 * 512;
constexpr size_t OUT_PFFN = OUT_PCONV + (size_t)4 * 2 * 1024;
constexpr size_t OUT_SGLA = OUT_PFFN + (size_t)4 * 2 * DFF;
constexpr size_t OUT_SCONV = OUT_SGLA + (size_t)NS * 4 * 256 * 512;
constexpr size_t OUT_SFFN = OUT_SCONV + (size_t)NS * 2 * 1024;

struct Params {
    const float* in[28];
    float* out;
    unsigned char* ws;
};
constexpr int TB1 = 768, TB2 = 2048, TB3 = 2304, TB4 = 2432, TB5 = 2560, TB6 = 2688, TB7 = 2816, TB8 = 3072, TB9 = 3760, TB10 = 4448, NTILES = 5136;

typedef __bf16 bf16x2_t __attribute__((ext_vector_type(2)));
typedef float f32x2_t __attribute__((ext_vector_type(2)));
__device__ __forceinline__ unsigned pk2(float lo, float hi) { f32x2_t v = {lo, hi}; bf16x2_t b = __builtin_convertvector(v, bf16x2_t); return __builtin_bit_cast(unsigned, b); }
__device__ __forceinline__ float bflo(unsigned w) { return __uint_as_float(w << 16); }
__device__ __forceinline__ float bfhi(unsigned w) { return __uint_as_float(w & 0xffff0000u); }
__device__ __forceinline__ float bf2f(bf16_t b) { return __uint_as_float(((unsigned)b) << 16); }
__device__ __forceinline__ float sigm(float x) { return __builtin_amdgcn_rcpf(1.0f + __expf(-x)); }
__device__ __forceinline__ float silu(float x) { return x * __builtin_amdgcn_rcpf(1.0f + __expf(-x)); }
__device__ __forceinline__ int otid() { int t = threadIdx.x; asm volatile("" : "+v"(t)); return t; }
__device__ __forceinline__ float wave_sum(float v) { for (int o = 32; o >= 1; o >>= 1) v += __shfl_xor(v, o); return v; }
__device__ __forceinline__ f32x4 mfma16(bf16x8 x, bf16x8 y, f32x4 c) { return __builtin_amdgcn_mfma_f32_16x16x32_bf16(x, y, c, 0, 0, 0); }
__device__ __forceinline__ bf16x8 ld8(const bf16_t* p) { return *(const bf16x8*)p; }
__device__ __forceinline__ void unpack8(u32x4 w, float (&f)[8]) { f[0] = bflo(w.x); f[1] = bfhi(w.x); f[2] = bflo(w.y); f[3] = bfhi(w.y); f[4] = bflo(w.z); f[5] = bfhi(w.z); f[6] = bflo(w.w); f[7] = bfhi(w.w); }
__device__ __forceinline__ u32x4 pack8(const float (&f)[8]) { u32x4 w; w.x = pk2(f[0], f[1]); w.y = pk2(f[2], f[3]); w.z = pk2(f[4], f[5]); w.w = pk2(f[6], f[7]); return w; }

__device__ __forceinline__ int inproj_mode(int col) { return col < 1024 ? 1 : col < 4096 ? 0 : col < 6144 ? 2 : col < 9216 ? 0 : col < 10240 ? 1 : 3; }
__device__ __forceinline__ f32x4 inproj_act(f32x4 v, int mode) {
    if (mode == 1) { v = v * 0.0625f; }
    else if (mode == 2) { v[0] = silu(v[0]); v[1] = silu(v[1]); v[2] = silu(v[2]); v[3] = silu(v[3]); }
    else if (mode == 3) { v[0] = sigm(v[0]); v[1] = sigm(v[1]); v[2] = sigm(v[2]); v[3] = sigm(v[3]); }
    return v;
}

#define XB_TMO      128
#define XB_XCNT(j)  (256  + 64 * (j))
#define XB_XSUB(j)  (1280 + 64 * (j))
#define XB_XGEN(j)  (2304 + 64 * (j))
#define XB_TOP      3328
#define XB_TOPGEN   3392
#define XCD_BAR_WORDS 3456
#define XB_SPIN_CAP (1u << 18)
#define LAS __attribute__((address_space(3)))

__device__ __forceinline__ unsigned xb_ld(unsigned* p)              { return __hip_atomic_load(p, __ATOMIC_RELAXED, __HIP_MEMORY_SCOPE_AGENT); }
__device__ __forceinline__ unsigned xb_add(unsigned* p, unsigned v) { return __hip_atomic_fetch_add(p, v, __ATOMIC_RELAXED, __HIP_MEMORY_SCOPE_AGENT); }
__device__ __forceinline__ unsigned xb_xcc_id() { return (unsigned)__builtin_amdgcn_s_getreg((3 << 11) | 20) & 0xFu; }
#define XB_SPIN(cond, bar) do { unsigned _sp = 0; while (cond) { __builtin_amdgcn_s_sleep(1); \
    if ((++_sp & 255u) == 0u) { if (xb_ld(&(bar)[XB_TMO])) break; if (_sp > XB_SPIN_CAP) { atomicAdd(&(bar)[XB_TMO], 1u); break; } } } } while (0)

struct XcdBarrier {
    unsigned* bar; unsigned x;
    volatile LAS unsigned* st;
};

__device__ __forceinline__ XcdBarrier xcd_barrier_post(unsigned* bar, volatile LAS unsigned* st) {
    XcdBarrier b; b.bar = bar; b.x = xb_xcc_id(); b.st = st;
    if (threadIdx.x == 0) (void)xb_add(&bar[XB_XCNT(b.x)], 1u);
    return b;
}
__device__ __forceinline__ void xcd_barrier_complete(unsigned* bar, unsigned x, unsigned& nloc, unsigned& nx) {
    const unsigned G = gridDim.x * gridDim.y * gridDim.z;
    unsigned sum, cnt, mine, sp = 0u;
    for (;;) {
        sum = 0u; cnt = 0u; mine = 0u;
#pragma unroll
        for (unsigned j = 0; j < 16; ++j) { const unsigned c = xb_ld(&bar[XB_XCNT(j)]); sum += c; cnt += (c > 0u) ? 1u : 0u; mine = (j == x) ? c : mine; }
        if (sum == G) break;
        __builtin_amdgcn_s_sleep(1);
        if ((++sp & 255u) == 0u) { if (xb_ld(&bar[XB_TMO])) break; if (sp > XB_SPIN_CAP) { atomicAdd(&bar[XB_TMO], 1u); break; } }
    }
    nloc = mine > 0u ? mine : 1u; nx = cnt > 0u ? cnt : 1u;
}

__device__ __forceinline__ void xcd_barrier(const XcdBarrier& b) {
    asm volatile("s_waitcnt vmcnt(0)" ::: "memory");
    __syncthreads();
    if (threadIdx.x == 0) {
        unsigned* bar = b.bar;
        __builtin_amdgcn_s_waitcnt(0);
        unsigned nloc = b.st[0], nx = b.st[1];
        if (nloc == 0u) { xcd_barrier_complete(bar, b.x, nloc, nx); b.st[0] = nloc; b.st[1] = nx; }
        const unsigned old = xb_add(&bar[XB_XSUB(b.x)], 1u);
        const unsigned gen = old / nloc;
        if (old + 1u == (gen + 1u) * nloc) {
            __builtin_amdgcn_fence(__ATOMIC_RELEASE, "agent");
            asm volatile("s_waitcnt vmcnt(0)" ::: "memory");
            const unsigned og = xb_add(&bar[XB_TOP], 1u);
            const unsigned tg = og / nx;
            if (og + 1u == (tg + 1u) * nx) xb_add(&bar[XB_TOPGEN], 1u);
            else XB_SPIN(xb_ld(&bar[XB_TOPGEN]) == tg, bar);
            __builtin_amdgcn_fence(__ATOMIC_ACQUIRE, "agent");
            xb_add(&bar[XB_XGEN(b.x)], 1u);
            asm volatile("s_waitcnt vmcnt(0)" ::: "memory");
        } else {
            XB_SPIN(xb_ld(&bar[XB_XGEN(b.x)]) == gen, bar);
            __builtin_amdgcn_fence(__ATOMIC_ACQUIRE, "agent");
            asm volatile("s_waitcnt vmcnt(0)" ::: "memory");
        }
    }
    __syncthreads();
}

struct EpiInproj {
    static constexpr bool PERM = true, AFTER_DRAIN = false;
    bf16_t* O;
    template <bool SIG> __device__ __forceinline__ void body(const f32x4 (&acc)[2][2][4][2], bf16_t* base, float ca, float cb, float cc) const {
#pragma unroll
        for (int ai = 0; ai < 2; ++ai)
#pragma unroll
            for (int m = 0; m < 4; ++m) { bf16_t* rowp = base + (size_t)(ai * 128 + m * 16) * LDP;
#pragma unroll
                for (int bj = 0; bj < 2; ++bj) { float y[8];
#pragma unroll
                    for (int e = 0; e < 8; ++e) { const float x = e < 4 ? acc[ai][bj][m][0][e & 3] : acc[ai][bj][m][1][e & 3];
                        if (SIG) { const float sg = __builtin_amdgcn_rcpf(1.0f + __expf(-x)); y[e] = sg * (cb + cc * x); }
                        else y[e] = ca * x; }
                    __builtin_nontemporal_store(pack8(y), (u32x4*)(rowp + bj * 128)); } }
    }
    __device__ __forceinline__ void operator()(const f32x4 (&acc)[2][2][4][2], const pg8::Unit& u, int wr, int wc, int fr, int fq) const {
        const int mode = inproj_mode(u.pn * 256);
        const float ca = mode == 1 ? 0.0625f : 1.0f, cb = mode == 3 ? 1.0f : 0.0f, cc = mode == 2 ? 1.0f : 0.0f;
        bf16_t* base = O + (size_t)(u.pm * 256 + wr * 64 + fr) * LDP + u.pn * 256 + wc * 32 + 8 * fq;
        if (mode >= 2) body<true>(acc, base, ca, cb, cc); else body<false>(acc, base, ca, cb, cc);
    }
};
struct EpiBf16 {
    static constexpr bool PERM = true, AFTER_DRAIN = false;
    bf16_t* O; int ldc;
    __device__ __forceinline__ void operator()(const f32x4 (&acc)[2][2][4][2], const pg8::Unit& u, int wr, int wc, int fr, int fq) const {
        const int row0 = u.pm * 256 + wr * 64 + fr, col0 = u.pn * 256 + wc * 32 + 8 * fq;
#pragma unroll
        for (int ai = 0; ai < 2; ++ai)
#pragma unroll
            for (int m = 0; m < 4; ++m) { bf16_t* rowp = O + (size_t)(row0 + ai * 128 + m * 16) * ldc + col0;
#pragma unroll
                for (int bj = 0; bj < 2; ++bj) { const f32x4 v0 = acc[ai][bj][m][0], v1 = acc[ai][bj][m][1];
                    u32x4 w; w.x = pk2(v0[0], v0[1]); w.y = pk2(v0[2], v0[3]); w.z = pk2(v1[0], v1[1]); w.w = pk2(v1[2], v1[3]);
                    *(u32x4*)(rowp + bj * 128) = w; } }
    }
};
struct EpiMerge {
    static constexpr bool PERM = true, AFTER_DRAIN = false;
    const bf16_t* P; float* MGf; bf16_t* MGb; int zoff, mode;
    __device__ __forceinline__ void operator()(const f32x4 (&acc)[2][2][4][2], const pg8::Unit& u, int wr, int wc, int fr, int fq) const {
        const int row0 = u.pm * 256 + wr * 64 + fr, col0 = u.pn * 256 + wc * 32 + 8 * fq;
#pragma unroll
        for (int ai = 0; ai < 2; ++ai)
#pragma unroll
            for (int m = 0; m < 4; ++m) { const size_t row = (size_t)(row0 + ai * 128 + m * 16);
#pragma unroll
                for (int bj = 0; bj < 2; ++bj) { const int col = col0 + bj * 128;
                    float g[8], v[8]; unpack8(__builtin_nontemporal_load((const u32x4*)(P + row * LDP + zoff + col)), g);
#pragma unroll
                    for (int e = 0; e < 4; ++e) { v[e] = g[e] * acc[ai][bj][m][0][e]; v[4 + e] = g[4 + e] * acc[ai][bj][m][1][e]; }
                    bf16_t* mp = MGb + row * D + col;
                    if (mode != 0) { float pv[8]; unpack8(*(const u32x4*)mp, pv);
#pragma unroll
                        for (int e = 0; e < 8; ++e) v[e] += pv[e]; }
                    *(u32x4*)mp = pack8(v); } }
    }
};
struct EpiResid {
    static constexpr bool PERM = false, AFTER_DRAIN = false;
    const float* resid; bf16_t* out;
    __device__ __forceinline__ void operator()(const f32x4 (&acc)[2][2][4][2], const pg8::Unit& u, int wr, int wc, int fr, int fq) const {
        const int row0 = u.pm * 256 + wr * 64 + fr, col0 = u.pn * 256 + wc * 32 + 4 * fq;
#pragma unroll
        for (int ai = 0; ai < 2; ++ai)
#pragma unroll
            for (int m = 0; m < 4; ++m) { const size_t ro = (size_t)(row0 + ai * 128 + m * 16) * D + col0;
#pragma unroll
                for (int bj = 0; bj < 2; ++bj)
#pragma unroll
                    for (int n = 0; n < 2; ++n) { const size_t o = ro + bj * 128 + n * 16;
                        const f32x4 y = *(const f32x4*)(resid + o) * DN_ALPHA + acc[ai][bj][m][n];
                        u32x2 w; w.x = pk2(y[0], y[1]); w.y = pk2(y[2], y[3]); *(u32x2*)(out + o) = w; } }
    }
};

struct EpiResidB {
    static constexpr bool PERM = true, AFTER_DRAIN = false;
    const bf16_t* resid; bf16_t* out;
    __device__ __forceinline__ void operator()(const f32x4 (&acc)[2][2][4][2], const pg8::Unit& u, int wr, int wc, int fr, int fq) const {
        const int row0 = u.pm * 256 + wr * 64 + fr, col0 = u.pn * 256 + wc * 32 + 8 * fq;
#pragma unroll
        for (int ai = 0; ai < 2; ++ai)
#pragma unroll
            for (int m = 0; m < 4; ++m) { const size_t ro = (size_t)(row0 + ai * 128 + m * 16) * D + col0;
#pragma unroll
                for (int bj = 0; bj < 2; ++bj) { const size_t o = ro + bj * 128;
                    float r[8], y[8]; unpack8(__builtin_nontemporal_load((const u32x4*)(resid + o)), r);
#pragma unroll
                    for (int e = 0; e < 4; ++e) { y[e] = r[e] * DN_ALPHA + acc[ai][bj][m][0][e]; y[4 + e] = r[4 + e] * DN_ALPHA + acc[ai][bj][m][1][e]; }
                    *(u32x4*)(out + o) = pack8(y); } }
    }
};
template <int RT, int CT, bool SWAP, int UNR = 2>
__device__ __forceinline__ void sk_mma(f32x4 (&acc)[RT][CT], const bf16_t* ap, size_t astep, const bf16_t* bp, size_t bstep, int ks0, int ks1) {
    int ks = ks0;
    for (; ks + UNR <= ks1; ks += UNR) {
        bf16x8 a[UNR][RT], b[UNR][CT];
#pragma unroll
        for (int u = 0; u < UNR; ++u) {
#pragma unroll
            for (int r = 0; r < RT; ++r) a[u][r] = ld8(ap + r * astep + 32 * (ks + u));
#pragma unroll
            for (int c = 0; c < CT; ++c) b[u][c] = ld8(bp + c * bstep + 32 * (ks + u)); }
#pragma unroll
        for (int u = 0; u < UNR; ++u)
#pragma unroll
            for (int r = 0; r < RT; ++r)
#pragma unroll
                for (int c = 0; c < CT; ++c) acc[r][c] = SWAP ? mfma16(a[u][r], b[u][c], acc[r][c]) : mfma16(b[u][c], a[u][r], acc[r][c]);
    }
    if (UNR > 2 && ks + 2 <= ks1) {
        bf16x8 a[2][RT], b[2][CT];
#pragma unroll
        for (int u = 0; u < 2; ++u) {
#pragma unroll
            for (int r = 0; r < RT; ++r) a[u][r] = ld8(ap + r * astep + 32 * (ks + u));
#pragma unroll
            for (int c = 0; c < CT; ++c) b[u][c] = ld8(bp + c * bstep + 32 * (ks + u)); }
#pragma unroll
        for (int u = 0; u < 2; ++u)
#pragma unroll
            for (int r = 0; r < RT; ++r)
#pragma unroll
                for (int c = 0; c < CT; ++c) acc[r][c] = SWAP ? mfma16(a[u][r], b[u][c], acc[r][c]) : mfma16(b[u][c], a[u][r], acc[r][c]);
        ks += 2;
    }
    for (; ks < ks1; ++ks) {
        bf16x8 a[RT], b[CT];
#pragma unroll
        for (int r = 0; r < RT; ++r) a[r] = ld8(ap + r * astep + 32 * ks);
#pragma unroll
        for (int c = 0; c < CT; ++c) b[c] = ld8(bp + c * bstep + 32 * ks);
#pragma unroll
        for (int r = 0; r < RT; ++r)
#pragma unroll
            for (int c = 0; c < CT; ++c) acc[r][c] = SWAP ? mfma16(a[r], b[c], acc[r][c]) : mfma16(b[c], a[r], acc[r][c]);
    }
}
template <int NTILE, class F>
__device__ __forceinline__ void sk_reduce(unsigned char* smem, const f32x4* acc, F&& epi) {
    f32x4* red = (f32x4*)smem; const int tid = otid(), w = tid >> 6, lane = tid & 63;
#pragma unroll
    for (int t = 0; t < NTILE; ++t) red[(w * NTILE + t) * 64 + lane] = acc[t];
    __syncthreads();
#pragma unroll
    for (int i = 0; i < (NTILE * 64 + 511) / 512; ++i) { const int s = tid + 512 * i;
        if (s < NTILE * 64) { f32x4 v = red[s];
#pragma unroll
            for (int wv = 1; wv < 8; ++wv) v = v + red[wv * NTILE * 64 + s];
            epi(i, s >> 6, s & 63, v); } }
    __syncthreads();
}
template <int RT, int CT> __device__ __forceinline__ void sk_zero(f32x4 (&acc)[RT][CT]) {
#pragma unroll
    for (int r = 0; r < RT; ++r)
#pragma unroll
        for (int c = 0; c < CT; ++c) acc[r][c] = (f32x4){0.f, 0.f, 0.f, 0.f};
}

__device__ __forceinline__ void phase_convert(const Params& p, unsigned char* smem) {
    float* T = (float*)smem;
    const int tid = otid(), G = gridDim.x;
    unsigned char* ws = p.ws;
    f32x4 pre[8];
    auto issue = [&](int tile, const float*& src, bf16_t*& dst, int& K, int& k0, int& n0) {
        src = p.in[8]; dst = (bf16_t*)(ws + O_WIN); int src_ld = WIN_LD, c0 = 0, ntn = 48, tb = 0; K = D;
#define TDSEL(TB, SRC, DST, LD, C0, KK, NN) if (tile >= (TB)) { src = (SRC); dst = (bf16_t*)(DST); src_ld = (LD); c0 = (C0); K = (KK); ntn = (NN) / 128; tb = (TB); }
        TDSEL(TB1, p.in[8], ws + O_WIN + (size_t)6144 * D * 2, WIN_LD, 6160, D, 10240)
        TDSEL(TB2, p.in[12], ws + O_WGO, D, 0, D, D)
        TDSEL(TB3, p.in[14], ws + O_WCO, D, 0, 1024, D)
        TDSEL(TB4, p.in[15], ws + O_WMKV, 1024, 0, D, 1024)
        TDSEL(TB5, p.in[16], ws + O_WMKV + (size_t)1024 * D * 2, 1024, 0, D, 1024)
        TDSEL(TB6, p.in[17], ws + O_WMO, D, 0, 1024, D)
        TDSEL(TB7, p.in[18], ws + O_WO, D, 0, D, D)
        TDSEL(TB8, p.in[21], ws + O_WGU, DFF, 0, D, DFF)
        TDSEL(TB9, p.in[22], ws + O_WGU + (size_t)DFF * D * 2, DFF, 0, D, DFF)
        TDSEL(TB10, p.in[25], ws + O_WD, D, 0, DFF, D)
#undef TDSEL
        const int lt = tile - tb, kt = lt / ntn, nt = lt - kt * ntn; k0 = kt * 128; n0 = nt * 128;
#pragma unroll
        for (int i = 0; i < 8; ++i) { const int f = tid + 512 * i, kk = f >> 5, n4 = f & 31;
            pre[i] = __builtin_nontemporal_load((const f32x4*)(src + (size_t)(k0 + kk) * src_ld + c0 + n0 + 4 * n4)); }
    };
    const float* src; bf16_t* dst; int K, k0, n0;
    auto tmap = [](int idx) { return idx + TB2 < NTILES ? idx + TB2 : idx + TB2 - NTILES; };
    if ((int)blockIdx.x < NTILES) issue(tmap(blockIdx.x), src, dst, K, k0, n0);
    for (int tile = blockIdx.x; tile < NTILES; tile += G) {
#pragma unroll
        for (int i = 0; i < 8; ++i) { const int f = tid + 512 * i, kk = f >> 5, n4 = f & 31; float* tp = T + kk * 133 + 4 * n4;
            tp[0] = pre[i][0]; tp[1] = pre[i][1]; tp[2] = pre[i][2]; tp[3] = pre[i][3]; }
        bf16_t* cdst = dst; const int cK = K, ck0 = k0, cn0 = n0;
        __syncthreads();
        if (tile + G < NTILES) issue(tmap(tile + G), src, dst, K, k0, n0);
#pragma unroll
        for (int i = 0; i < 4; ++i) { const int it = tid + 512 * i, kg = it & 15, n = it >> 4;
            float f[8];
#pragma unroll
            for (int e = 0; e < 8; ++e) f[e] = T[(8 * kg + e) * 133 + n];
            *(u32x4*)(cdst + (size_t)(cn0 + n) * cK + ck0 + 8 * kg) = pack8(f); }
        __syncthreads();
    }
    bf16_t* Xb = (bf16_t*)(ws + O_XB); bf16_t* Memb = (bf16_t*)(ws + O_MEMB); bf16_t* X1b = (bf16_t*)(ws + O_X1B); bf16_t* Walr = (bf16_t*)(ws + O_WALR);
    const size_t stride = (size_t)G * 512, t0 = (size_t)blockIdx.x * 512 + tid;
    for (size_t it = t0; it < (size_t)NRP * 256; it += stride) { const int row = (int)(it >> 8), c8 = (int)(it & 255) * 8;
        u32x4 w = {0u, 0u, 0u, 0u};
        if (row < NR) { const float* s = row < NP ? p.in[0] + (size_t)row * D + c8 : p.in[1] + (size_t)(row - NP) * D + c8;
            const f32x4 a = *(const f32x4*)s, b = *(const f32x4*)(s + 4);
            w.x = pk2(a[0], a[1]); w.y = pk2(a[2], a[3]); w.z = pk2(b[0], b[1]); w.w = pk2(b[2], b[3]); }
        else { *(u32x4*)(X1b + (size_t)row * D + c8) = w; }
        *(u32x4*)(Xb + (size_t)row * D + c8) = w; }
    for (size_t it = t0; it < (size_t)1024 * 256; it += stride) { const float* s = p.in[2] + it * 8;
        const f32x4 a = *(const f32x4*)s, b = *(const f32x4*)(s + 4); u32x4 w;
        w.x = pk2(a[0], a[1]); w.y = pk2(a[2], a[3]); w.z = pk2(b[0], b[1]); w.w = pk2(b[2], b[3]);
        *(u32x4*)(Memb + it * 8) = w; }
    for (size_t it = t0; it < (size_t)16 * D; it += stride) { const int r = (int)(it >> 11), k = (int)(it & 2047);
        const float v = p.in[8][(size_t)k * WIN_LD + 6144 + r]; Walr[it] = (bf16_t)(pk2(v, 0.f) & 0xffffu); }
}

__device__ __forceinline__ void p1_sample_inproj(const Params& p, unsigned char* smem, int j) {
    const int tid = otid(), w = tid >> 6, lane = tid & 63, fr = lane & 15, fq = lane >> 4;
    const bf16_t* Xb = (const bf16_t*)(p.ws + O_XB); const bf16_t* Win = (const bf16_t*)(p.ws + O_WIN); bf16_t* P = (bf16_t*)(p.ws + O_P);
    const int col0 = 64 * (j >> 1), row0 = NP + 64 * (j & 1);
    f32x4 acc[4][4]; sk_zero(acc);
    sk_mma<4, 4, false, 2>(acc, Xb + (size_t)(row0 + fr) * D + 8 * fq, (size_t)16 * D, Win + (size_t)(col0 + fr) * D + 8 * fq, (size_t)16 * D, 8 * w, 8 * w + 8);
    const int mode = inproj_mode(col0);
    sk_reduce<16>(smem, &acc[0][0], [&](int, int t, int ln, f32x4 v) { const int rt = t >> 2, ct = t & 3, r = ln & 15, q = ln >> 4;
        v = inproj_act(v, mode); u32x2 o; o.x = pk2(v[0], v[1]); o.y = pk2(v[2], v[3]);
        *(u32x2*)(P + (size_t)(row0 + 16 * rt + r) * LDP + col0 + 16 * ct + 4 * q) = o; });
}
__device__ __forceinline__ void p1_memkv(const Params& p, unsigned char* smem, int j) {
    const int tid = otid(), w = tid >> 6, lane = tid & 63, fr = lane & 15, fq = lane >> 4;
    const bf16_t* Memb = (const bf16_t*)(p.ws + O_MEMB); const bf16_t* Wm = (const bf16_t*)(p.ws + O_WMKV);
    bf16_t* MKb = (bf16_t*)(p.ws + O_MKB); bf16_t* MVT = (bf16_t*)(p.ws + O_MVT);
    const int rb = j >> 5, cb = j & 31, col0 = 64 * cb, arow0 = 64 * rb;
    f32x4 acc[4][4]; sk_zero(acc);
    const bf16_t* ap = Memb + (size_t)(arow0 + fr) * D + 8 * fq; const bf16_t* bp = Wm + (size_t)(col0 + fr) * D + 8 * fq;
    float* out = p.out;
    if (col0 < 1024) {
        sk_mma<4, 4, false, 2>(acc, ap, (size_t)16 * D, bp, (size_t)16 * D, 8 * w, 8 * w + 8);
        sk_reduce<16>(smem, &acc[0][0], [&](int, int t, int ln, f32x4 v) { const int rt = t >> 2, ct = t & 3, r = ln & 15, q = ln >> 4;
            const int row = arow0 + 16 * rt + r, col = col0 + 16 * ct + 4 * q;
            *(f32x4*)(out + OUT_PMK + (size_t)row * 1024 + col) = v;
            u32x2 o; o.x = pk2(v[0], v[1]); o.y = pk2(v[2], v[3]); *(u32x2*)(MKb + (size_t)row * 1024 + col) = o; });
    } else {
        sk_mma<4, 4, true, 2>(acc, ap, (size_t)16 * D, bp, (size_t)16 * D, 8 * w, 8 * w + 8);
        sk_reduce<16>(smem, &acc[0][0], [&](int, int t, int ln, f32x4 v) { const int rt = t >> 2, ct = t & 3, r = ln & 15, q = ln >> 4;
            const int row = arow0 + 16 * rt + 4 * q, c = col0 - 1024 + 16 * ct + r, b = row >> 8, mloc = row & 255;
#pragma unroll
            for (int e = 0; e < 4; ++e) out[OUT_PMV + (size_t)(row + e) * 1024 + c] = v[e];
            u32x2 o; o.x = pk2(v[0], v[1]); o.y = pk2(v[2], v[3]); *(u32x2*)(MVT + ((size_t)b * 1024 + c) * 256 + mloc) = o; });
    }
}
__device__ __forceinline__ void p1_alr(const Params& p, unsigned char* smem, int j2) {
    const int tid = otid(), w = tid >> 6, lane = tid & 63, fr = lane & 15, fq = lane >> 4;
    const int j = j2 >> 1, half = j2 & 1;
    const bf16_t* Xb = (const bf16_t*)(p.ws + O_XB); const bf16_t* Walr = (const bf16_t*)(p.ws + O_WALR); float* BC = (float*)(p.ws + O_BC);
    float* alr = (float*)(smem + 32768);
    const int k = half * 512 + tid;
    float w2[16];
#pragma unroll
    for (int r = 0; r < 16; ++r) w2[r] = p.in[9][r * 1024 + k];
    const float bb = p.in[10][k];
    { f32x4 acc[4][1]; sk_zero(acc);
      sk_mma<4, 1, false, 4>(acc, Xb + (size_t)(64 * j + fr) * D + 8 * fq, (size_t)16 * D, Walr + (size_t)fr * D + 8 * fq, 0, 8 * w, 8 * w + 8);
      sk_reduce<4>(smem, &acc[0][0], [&](int, int t, int ln, f32x4 v) { *(f32x4*)(alr + (16 * t + (ln & 15)) * 16 + 4 * (ln >> 4)) = v; }); }
    const bool prompt = (64 * j) < NP;
    float run = 0.f;
    float* bcp = BC + (size_t)(64 * j) * 1024 + k;
#pragma unroll 4
    for (int t = 0; t < 64; ++t) { float z = bb;
#pragma unroll
        for (int r4 = 0; r4 < 4; ++r4) { const f32x4 a = *(const f32x4*)(alr + t * 16 + 4 * r4); z += a[0] * w2[4 * r4] + a[1] * w2[4 * r4 + 1] + a[2] * w2[4 * r4 + 2] + a[3] * w2[4 * r4 + 3]; }
        const float la = (fminf(z, 0.f) - __logf(1.0f + __expf(-fabsf(z)))) * 0.0625f;
        run = prompt ? run + la : la;
        bcp[(size_t)t * 1024] = run; }
    __syncthreads();
}

constexpr int QS = 264, TS = 72;
__device__ __forceinline__ void gla_prompt_job(const Params& p, unsigned char* smem, int g) {
    const int tid = otid(), w = tid >> 6, lane = tid & 63, fr = lane & 15, fq = lane >> 4;
    const int b = g >> 5, h = (g >> 3) & 3, j = g & 7;
    const bf16_t* P = (const bf16_t*)(p.ws + O_P); const float* BC = (const float*)(p.ws + O_BC); bf16_t* OG = (bf16_t*)(p.ws + O_OG);
    bf16_t* Qt = (bf16_t*)smem; bf16_t* Kt = Qt + 64 * QS; bf16_t* ST = Kt + 64 * QS; bf16_t* KtT = ST + 64 * QS; bf16_t* VT = KtT + 256 * TS; bf16_t* Pm = VT + 64 * TS;
    float* Dk = (float*)(Pm + 64 * TS);
    for (int i = tid; i < 64 * QS / 8; i += 512) ((u32x4*)ST)[i] = (u32x4){0u, 0u, 0u, 0u};
    f32x4 sacc[2][4];
#pragma unroll
    for (int a = 0; a < 2; ++a)
#pragma unroll
        for (int c = 0; c < 4; ++c) sacc[a][c] = (f32x4){0.f, 0.f, 0.f, 0.f};
    const size_t R0 = (size_t)b * 2048;
    u32x4 pq[4], pk[4], pv; f32x4 pb0[4], pb1[4]; float pd = 0.f;
#define GLA_PREFETCH(RB) do { const size_t rb_ = (RB); \
        _Pragma("unroll") for (int i = 0; i < 4; ++i) { const int s = tid + 512 * i, t = s >> 5, ks = s & 31; \
            const bf16_t* prow = P + (rb_ + t) * LDP + h * 256 + 8 * ks; pq[i] = *(const u32x4*)(prow + Q_OFF); pk[i] = *(const u32x4*)(prow + K_OFF); \
            const float* bcp = BC + (rb_ + t) * 1024 + h * 256 + 8 * ks; pb0[i] = *(const f32x4*)bcp; pb1[i] = *(const f32x4*)(bcp + 4); } \
        pv = *(const u32x4*)(P + (rb_ + (tid >> 3)) * LDP + V_OFF + h * 512 + j * 64 + 8 * (tid & 7)); \
        if (tid < 256) pd = BC[(rb_ + 63) * 1024 + h * 256 + tid]; } while (0)
    GLA_PREFETCH(R0);
    for (int n = 0; n < 32; ++n) {
        const size_t r0 = R0 + 64 * n;
#pragma unroll
        for (int i = 0; i < 4; ++i) { const int s = tid + 512 * i, t = s >> 5, ks = s & 31;
            float qf[8], kf[8]; unpack8(pq[i], qf); unpack8(pk[i], kf);
#pragma unroll
            for (int e = 0; e < 8; ++e) { const float bc = e < 4 ? pb0[i][e & 3] : pb1[i][e & 3]; qf[e] *= __expf(bc); kf[e] *= __expf(-bc); }
            *(u32x4*)(Qt + t * QS + 8 * ks) = pack8(qf); *(u32x4*)(Kt + t * QS + 8 * ks) = pack8(kf); }
        { const int t = tid >> 3, vs = tid & 7; const u32x4 v8 = pv;
            bf16_t* vp = VT + (8 * vs) * TS + t;
            vp[0 * TS] = (bf16_t)(v8.x & 0xffffu); vp[1 * TS] = (bf16_t)(v8.x >> 16); vp[2 * TS] = (bf16_t)(v8.y & 0xffffu); vp[3 * TS] = (bf16_t)(v8.y >> 16);
            vp[4 * TS] = (bf16_t)(v8.z & 0xffffu); vp[5 * TS] = (bf16_t)(v8.z >> 16); vp[6 * TS] = (bf16_t)(v8.w & 0xffffu); vp[7 * TS] = (bf16_t)(v8.w >> 16); }
        if (tid < 256) Dk[tid] = __expf(pd);
        if (n + 1 < 32) GLA_PREFETCH(r0 + 64);
        __syncthreads();
#pragma unroll
        for (int i = 0; i < 4; ++i) { const int s = tid + 512 * i, t = s & 63, ks = s >> 6;
            const u32x4 k8 = *(const u32x4*)(Kt + t * QS + 8 * ks);
            bf16_t* kp = KtT + (8 * ks) * TS + t;
            kp[0 * TS] = (bf16_t)(k8.x & 0xffffu); kp[1 * TS] = (bf16_t)(k8.x >> 16); kp[2 * TS] = (bf16_t)(k8.y & 0xffffu); kp[3 * TS] = (bf16_t)(k8.y >> 16);
            kp[4 * TS] = (bf16_t)(k8.z & 0xffffu); kp[5 * TS] = (bf16_t)(k8.z >> 16); kp[6 * TS] = (bf16_t)(k8.w & 0xffffu); kp[7 * TS] = (bf16_t)(k8.w >> 16); }
#pragma unroll
        for (int i = 0; i < 2; ++i) { const int T = 2 * w + i, tt = T >> 2, st = T & 3;
            f32x4 a = (f32x4){0.f, 0.f, 0.f, 0.f};
            if (st <= tt) {
#pragma unroll
                for (int ks = 0; ks < 8; ++ks) a = mfma16(ld8(Kt + (16 * st + fr) * QS + 32 * ks + 8 * fq), ld8(Qt + (16 * tt + fr) * QS + 32 * ks + 8 * fq), a); }
            const int tl = 16 * tt + fr, sl = 16 * st + 4 * fq;
#pragma unroll
            for (int r = 0; r < 4; ++r) if (sl + r > tl) a[r] = 0.f;
            u32x2 o; o.x = pk2(a[0], a[1]); o.y = pk2(a[2], a[3]); *(u32x2*)(Pm + tl * TS + sl) = o; }
        __syncthreads();
#pragma unroll
        for (int i = 0; i < 2; ++i) { const int T = 2 * w + i, tt = T >> 2, vt = T & 3;
            f32x4 a = (f32x4){0.f, 0.f, 0.f, 0.f};
#pragma unroll
            for (int ks = 0; ks < 2; ++ks) a = mfma16(ld8(VT + (16 * vt + fr) * TS + 32 * ks + 8 * fq), ld8(Pm + (16 * tt + fr) * TS + 32 * ks + 8 * fq), a);
#pragma unroll
            for (int ks = 0; ks < 8; ++ks) a = mfma16(ld8(ST + (16 * vt + fr) * QS + 32 * ks + 8 * fq), ld8(Qt + (16 * tt + fr) * QS + 32 * ks + 8 * fq), a);
            u32x2 ow; ow.x = pk2(a[0], a[1]); ow.y = pk2(a[2], a[3]); *(u32x2*)(OG + (r0 + 16 * tt + fr) * D + h * 512 + j * 64 + 16 * vt + 4 * fq) = ow; }
        __syncthreads();
#pragma unroll
        for (int k2 = 0; k2 < 2; ++k2) { const int kt = 2 * w + k2;
            const bf16x8 X0 = ld8(KtT + (16 * kt + fr) * TS + 8 * fq), X1 = ld8(KtT + (16 * kt + fr) * TS + 32 + 8 * fq);
            const f32x4 dk = *(const f32x4*)(Dk + 16 * kt + 4 * fq);
#pragma unroll
            for (int vt = 0; vt < 4; ++vt) { f32x4 a = sacc[k2][vt];
                a = mfma16(X0, ld8(VT + (16 * vt + fr) * TS + 8 * fq), a); a = mfma16(X1, ld8(VT + (16 * vt + fr) * TS + 32 + 8 * fq), a);
                a = a * dk; sacc[k2][vt] = a;
                u32x2 o; o.x = pk2(a[0], a[1]); o.y = pk2(a[2], a[3]); *(u32x2*)(ST + (16 * vt + fr) * QS + 16 * kt + 4 * fq) = o; } }
        __syncthreads();
    }
#undef GLA_PREFETCH
    float* so = p.out + OUT_PGLA + ((size_t)(b * 4 + h) * 256) * 512 + j * 64;
#pragma unroll
    for (int k2 = 0; k2 < 2; ++k2)
#pragma unroll
        for (int vt = 0; vt < 4; ++vt)
#pragma unroll
            for (int r = 0; r < 4; ++r) so[(size_t)(16 * (2 * w + k2) + 4 * fq + r) * 512 + 16 * vt + fr] = sacc[k2][vt][r];
}

__device__ __forceinline__ void gla_sample_job(const Params& p, unsigned char* smem, int jb) {
    const int tid = otid(); const int b = jb >> 2, h = jb & 3;
    const bf16_t* P = (const bf16_t*)(p.ws + O_P); const float* BC = (const float*)(p.ws + O_BC); bf16_t* OG = (bf16_t*)(p.ws + O_OG);
    float* sq = (float*)smem; float* sk = sq + 256; float* sa = sk + 256; float* red = sa + 256;
    const size_t row = (size_t)NP + b;
    if (tid < 256) { const bf16_t* prow = P + row * LDP + h * 256 + tid; sq[tid] = bf2f(prow[Q_OFF]); sk[tid] = bf2f(prow[K_OFF]); sa[tid] = __expf(BC[row * 1024 + h * 256 + tid]); }
    const int v4 = tid & 127, kg = tid >> 7;
    const u32x2 vv = *(const u32x2*)(P + row * LDP + V_OFF + h * 512 + 4 * v4);
    f32x4 v; v[0] = bflo(vv.x); v[1] = bfhi(vv.x); v[2] = bflo(vv.y); v[3] = bfhi(vv.y);
    const f32x4* Sin = (const f32x4*)(p.in[5] + ((size_t)(b * 4 + h) * 256 + kg * 64) * 512) + v4;
    f32x4* Sout = (f32x4*)(p.out + OUT_SGLA + ((size_t)(b * 4 + h) * 256 + kg * 64) * 512) + v4;
    f32x4 s0[16];
#pragma unroll
    for (int i = 0; i < 16; ++i) s0[i] = __builtin_nontemporal_load(Sin + (size_t)i * 128);
    __syncthreads();
    f32x4 o = (f32x4){0.f, 0.f, 0.f, 0.f};
    for (int k0 = 0; k0 < 64; k0 += 16) {
        f32x4 s[16];
#pragma unroll
        for (int i = 0; i < 16; ++i) s[i] = s0[i];
        if (k0 + 16 < 64) {
#pragma unroll
            for (int i = 0; i < 16; ++i) s0[i] = __builtin_nontemporal_load(Sin + (size_t)(k0 + 16 + i) * 128); }
#pragma unroll
        for (int i = 0; i < 16; ++i) { const int k = kg * 64 + k0 + i;
            s[i] = s[i] * sa[k] + v * sk[k];
            __builtin_nontemporal_store(s[i], Sout + (size_t)(k0 + i) * 128);
            o = o + s[i] * sq[k]; }
    }
    *(f32x4*)(red + kg * 512 + 4 * v4) = o;
    __syncthreads();
    if (tid < 128) { const f32x4 r = *(const f32x4*)(red + 4 * tid) + *(const f32x4*)(red + 512 + 4 * tid) + *(const f32x4*)(red + 1024 + 4 * tid) + *(const f32x4*)(red + 1536 + 4 * tid);
        u32x2 ow; ow.x = pk2(r[0], r[1]); ow.y = pk2(r[2], r[3]); *(u32x2*)(OG + row * D + h * 512 + 4 * tid) = ow; }
    __syncthreads();
}

__device__ __forceinline__ void attn_prompt_job(const Params& p, int j) {
    const int tid = otid(), w = tid >> 6, lane = tid & 63, fr = lane & 15, fq = lane >> 4;
    const int b = j >> 6, h = (j >> 4) & 3, qt = j & 15;
    const bf16_t* P = (const bf16_t*)(p.ws + O_P); const bf16_t* MKb = (const bf16_t*)(p.ws + O_MKB); const bf16_t* MVT = (const bf16_t*)(p.ws + O_MVT); bf16_t* Am = (bf16_t*)(p.ws + O_AM);
    const size_t row = (size_t)b * 2048 + qt * 128 + 16 * w + fr;
    const bf16_t* qp = P + row * LDP + MQ_OFF + h * 256 + 8 * fq;
    bf16x8 Yq[8];
#pragma unroll
    for (int ks = 0; ks < 8; ++ks) Yq[ks] = ld8(qp + 32 * ks);
    f32x4 lg[16];
    const bf16_t* kp = MKb + (size_t)(b * 256 + fr) * 1024 + h * 256 + 8 * fq;
#pragma unroll
    for (int m2 = 0; m2 < 8; ++m2) {
        bf16x8 kf[2][8];
#pragma unroll
        for (int t = 0; t < 2; ++t)
#pragma unroll
            for (int ks = 0; ks < 8; ++ks) kf[t][ks] = ld8(kp + (size_t)(2 * m2 + t) * 16 * 1024 + 32 * ks);
#pragma unroll
        for (int t = 0; t < 2; ++t) { f32x4 a = (f32x4){0.f, 0.f, 0.f, 0.f};
#pragma unroll
            for (int ks = 0; ks < 8; ++ks) a = mfma16(kf[t][ks], Yq[ks], a);
            lg[2 * m2 + t] = a; } }
    float mx = -3.0e38f;
#pragma unroll
    for (int mt = 0; mt < 16; ++mt) mx = fmaxf(fmaxf(fmaxf(lg[mt][0], lg[mt][1]), fmaxf(lg[mt][2], lg[mt][3])), mx);
    mx = fmaxf(mx, __shfl_xor(mx, 16)); mx = fmaxf(mx, __shfl_xor(mx, 32));
    float sum = 0.f;
    bf16x8 Yp[8];
#pragma unroll
    for (int i = 0; i < 8; ++i) { u32x4 wv; f32x4 e0, e1;
#pragma unroll
        for (int r = 0; r < 4; ++r) { e0[r] = __expf(lg[2 * i][r] - mx); e1[r] = __expf(lg[2 * i + 1][r] - mx); }
        sum += (e0[0] + e0[1]) + (e0[2] + e0[3]) + (e1[0] + e1[1]) + (e1[2] + e1[3]);
        wv.x = pk2(e0[0], e0[1]); wv.y = pk2(e0[2], e0[3]); wv.z = pk2(e1[0], e1[1]); wv.w = pk2(e1[2], e1[3]);
        Yp[i] = __builtin_bit_cast(bf16x8, wv); }
    sum += __shfl_xor(sum, 16); sum += __shfl_xor(sum, 32);
    const float inv = 1.0f / sum;
    const bf16_t* vp = MVT + ((size_t)b * 1024 + h * 256 + fr) * 256 + 4 * fq;
    bf16_t* op = Am + row * 1024 + h * 256 + 4 * fq;
    u32x2 vf[2][2][8][2];
#pragma unroll
    for (int t = 0; t < 2; ++t)
#pragma unroll
        for (int i = 0; i < 8; ++i) { vf[0][t][i][0] = *(const u32x2*)(vp + (size_t)t * 16 * 256 + 32 * i); vf[0][t][i][1] = *(const u32x2*)(vp + (size_t)t * 16 * 256 + 32 * i + 16); }
#pragma unroll
    for (int d2 = 0; d2 < 8; ++d2) {
        if (d2 + 1 < 8) {
#pragma unroll
            for (int t = 0; t < 2; ++t)
#pragma unroll
                for (int i = 0; i < 8; ++i) { const bf16_t* q = vp + (size_t)(2 * (d2 + 1) + t) * 16 * 256 + 32 * i;
                    vf[(d2 + 1) & 1][t][i][0] = *(const u32x2*)q; vf[(d2 + 1) & 1][t][i][1] = *(const u32x2*)(q + 16); } }
#pragma unroll
        for (int t = 0; t < 2; ++t) { f32x4 a = (f32x4){0.f, 0.f, 0.f, 0.f};
#pragma unroll
            for (int i = 0; i < 8; ++i) { u32x4 xv; xv.x = vf[d2 & 1][t][i][0].x; xv.y = vf[d2 & 1][t][i][0].y; xv.z = vf[d2 & 1][t][i][1].x; xv.w = vf[d2 & 1][t][i][1].y;
                a = mfma16(__builtin_bit_cast(bf16x8, xv), Yp[i], a); }
            a = a * inv; u32x2 o; o.x = pk2(a[0], a[1]); o.y = pk2(a[2], a[3]); *(u32x2*)(op + 16 * (2 * d2 + t)) = o; } }
}

__device__ __forceinline__ void attn_sample_job(const Params& p, unsigned char* smem, int b) {
    const int tid = otid(), w = tid >> 6, lane = tid & 63;
    const bf16_t* P = (const bf16_t*)(p.ws + O_P); bf16_t* Am = (bf16_t*)(p.ws + O_AM);
    float* sq = (float*)smem; float* lg = sq + 1024; f32x4* red = (f32x4*)(smem + 8192);
    for (int i = tid; i < 1024; i += 512) sq[i] = bf2f(P[(size_t)(NP + b) * LDP + MQ_OFF + i]);
    const f32x4* kc = (const f32x4*)(p.in[3] + (size_t)b * 256 * 1024) + (size_t)w * 128 * 64 + lane;
    f32x4 k0[8];
#pragma unroll
    for (int i = 0; i < 8; ++i) k0[i] = __builtin_nontemporal_load(kc + (size_t)i * 64);
    __syncthreads();
    for (int r0 = 0; r0 < 128; r0 += 8) {
        f32x4 kv[8];
#pragma unroll
        for (int i = 0; i < 8; ++i) kv[i] = k0[i];
        if (r0 + 8 < 128) {
#pragma unroll
            for (int i = 0; i < 8; ++i) k0[i] = __builtin_nontemporal_load(kc + (size_t)(r0 + 8 + i) * 64); }
#pragma unroll
        for (int i = 0; i < 8; ++i) { const int rho = w * 128 + r0 + i, hh = rho & 3;
            const f32x4 qv = *(const f32x4*)(sq + hh * 256 + 4 * lane);
            float d = kv[i][0] * qv[0] + kv[i][1] * qv[1] + kv[i][2] * qv[2] + kv[i][3] * qv[3];
            d = wave_sum(d);
            if (lane == 0) lg[hh * 256 + (rho >> 2)] = d; }
    }
    __syncthreads();
    if (w < 4) { float l[4]; float mx = -3.0e38f;
#pragma unroll
        for (int i = 0; i < 4; ++i) { l[i] = lg[w * 256 + lane + 64 * i]; mx = fmaxf(mx, l[i]); }
        for (int o = 32; o >= 1; o >>= 1) mx = fmaxf(mx, __shfl_xor(mx, o));
        float sm = 0.f;
#pragma unroll
        for (int i = 0; i < 4; ++i) { l[i] = __expf(l[i] - mx); sm += l[i]; }
        sm = wave_sum(sm); const float inv = 1.0f / sm;
#pragma unroll
        for (int i = 0; i < 4; ++i) lg[w * 256 + lane + 64 * i] = l[i] * inv; }
    const int c4 = tid & 255, mh = tid >> 8, hh = c4 >> 6;
    const f32x4* vc = (const f32x4*)(p.in[4] + (size_t)b * 256 * 1024) + (size_t)mh * 128 * 256 + c4;
    f32x4 v0[16];
#pragma unroll
    for (int i = 0; i < 16; ++i) v0[i] = __builtin_nontemporal_load(vc + (size_t)i * 256);
    __syncthreads();
    f32x4 a = (f32x4){0.f, 0.f, 0.f, 0.f};
    for (int m0 = 0; m0 < 128; m0 += 16) {
        f32x4 vv[16];
#pragma unroll
        for (int i = 0; i < 16; ++i) vv[i] = v0[i];
        if (m0 + 16 < 128) {
#pragma unroll
            for (int i = 0; i < 16; ++i) v0[i] = __builtin_nontemporal_load(vc + (size_t)(m0 + 16 + i) * 256); }
#pragma unroll
        for (int i = 0; i < 16; ++i) a = a + vv[i] * lg[hh * 256 + mh * 128 + m0 + i];
    }
    red[mh * 256 + c4] = a;
    __syncthreads();
    if (tid < 256) { const f32x4 r = red[tid] + red[256 + tid]; u32x2 o; o.x = pk2(r[0], r[1]); o.y = pk2(r[2], r[3]);
        *(u32x2*)(Am + (size_t)(NP + b) * 1024 + 4 * tid) = o; }
    __syncthreads();
}

__device__ __forceinline__ void conv_job(const Params& p, int jc) {
    const int tid = otid(), seg = tid & 127, run = tid >> 7, c = 8 * seg;
    const bf16_t* P = (const bf16_t*)(p.ws + O_P); bf16_t* Ab = (bf16_t*)(p.ws + O_AB);
    const float* wc = p.in[13];
    float w0[8], w1[8], w2[8];
    { const f32x4 a0 = *(const f32x4*)(wc + c), a1 = *(const f32x4*)(wc + c + 4), b0 = *(const f32x4*)(wc + 1024 + c), b1 = *(const f32x4*)(wc + 1024 + c + 4), c0 = *(const f32x4*)(wc + 2048 + c), c1 = *(const f32x4*)(wc + 2048 + c + 4);
#pragma unroll
      for (int e = 0; e < 4; ++e) { w0[e] = a0[e]; w0[4 + e] = a1[e]; w1[e] = b0[e]; w1[4 + e] = b1[e]; w2[e] = c0[e]; w2[4 + e] = c1[e]; } }
    const int rowb = 128 * jc + 32 * run;
    const bf16_t* pb = P + (size_t)rowb * LDP + c;
    if (rowb < NP) {
        const int t0 = rowb & 2047, b = rowb >> 11;
        float u0[8], u1[8];
#pragma unroll
        for (int e = 0; e < 8; ++e) { u0[e] = 0.f; u1[e] = 0.f; }
        if (t0 >= 2) { float a[8], bq[8];
            unpack8(*(const u32x4*)(pb - 2 * LDP + CC_OFF), a); unpack8(*(const u32x4*)(pb - 2 * LDP + CH_OFF), bq);
#pragma unroll
            for (int e = 0; e < 8; ++e) u0[e] = a[e] * bq[e];
            unpack8(*(const u32x4*)(pb - LDP + CC_OFF), a); unpack8(*(const u32x4*)(pb - LDP + CH_OFF), bq);
#pragma unroll
            for (int e = 0; e < 8; ++e) u1[e] = a[e] * bq[e]; }
        for (int r0 = 0; r0 < 32; r0 += 4) {
            u32x4 xc[4], xh[4], xb[4];
#pragma unroll
            for (int i = 0; i < 4; ++i) { const bf16_t* pr = pb + (size_t)(r0 + i) * LDP; xc[i] = *(const u32x4*)(pr + CC_OFF); xh[i] = *(const u32x4*)(pr + CH_OFF); xb[i] = *(const u32x4*)(pr + CB_OFF); }
#pragma unroll
            for (int i = 0; i < 4; ++i) { float a[8], bq[8], cb[8], u2[8], y[8];
                unpack8(xc[i], a); unpack8(xh[i], bq); unpack8(xb[i], cb);
#pragma unroll
                for (int e = 0; e < 8; ++e) { u2[e] = a[e] * bq[e]; y[e] = cb[e] * (w0[e] * u0[e] + w1[e] * u1[e] + w2[e] * u2[e]); u0[e] = u1[e]; u1[e] = u2[e]; }
                *(u32x4*)(Ab + (size_t)(rowb + r0 + i) * 1024 + c) = pack8(y);
                const int t = t0 + r0 + i;
                if (t >= 2046) { float* so = p.out + OUT_PCONV + (size_t)(b * 2 + (t - 2046)) * 1024 + c;
#pragma unroll
                    for (int e = 0; e < 8; ++e) so[e] = u2[e]; } }
        }
    } else {
        for (int r0 = 0; r0 < 32; r0 += 4) {
            u32x4 xc[4], xh[4], xb[4]; f32x4 st[4][4];
#pragma unroll
            for (int i = 0; i < 4; ++i) { const bf16_t* pr = pb + (size_t)(r0 + i) * LDP; xc[i] = *(const u32x4*)(pr + CC_OFF); xh[i] = *(const u32x4*)(pr + CH_OFF); xb[i] = *(const u32x4*)(pr + CB_OFF);
                const float* sc = p.in[6] + (size_t)(rowb - NP + r0 + i) * 2048 + c;
                st[i][0] = *(const f32x4*)sc; st[i][1] = *(const f32x4*)(sc + 4); st[i][2] = *(const f32x4*)(sc + 1024); st[i][3] = *(const f32x4*)(sc + 1028); }
#pragma unroll
            for (int i = 0; i < 4; ++i) { float a[8], bq[8], cb[8], y[8]; f32x4 un0, un1;
                unpack8(xc[i], a); unpack8(xh[i], bq); unpack8(xb[i], cb);
#pragma unroll
                for (int e = 0; e < 8; ++e) { const float u0 = e < 4 ? st[i][0][e & 3] : st[i][1][e & 3], u1 = e < 4 ? st[i][2][e & 3] : st[i][3][e & 3], u2 = a[e] * bq[e];
                    y[e] = cb[e] * (w0[e] * u0 + w1[e] * u1 + w2[e] * u2); if (e < 4) un0[e & 3] = u2; else un1[e & 3] = u2; }
                const size_t bs = (size_t)(rowb - NP + r0 + i);
                *(u32x4*)(Ab + (size_t)(rowb + r0 + i) * 1024 + c) = pack8(y);
                float* so = p.out + OUT_SCONV + bs * 2048 + c;
                *(f32x4*)so = st[i][2]; *(f32x4*)(so + 4) = st[i][3]; *(f32x4*)(so + 1024) = un0; *(f32x4*)(so + 1028) = un1; }
        }
    }
}

__device__ __forceinline__ void phase_gla_norm(const Params& p) {
    const int tid = otid(), w = tid >> 6, lane = tid & 63;
    const bf16_t* P = (const bf16_t*)(p.ws + O_P); const bf16_t* OG = (const bf16_t*)(p.ws + O_OG); bf16_t* Aa = (bf16_t*)(p.ws + O_AA);
    const f32x4 g0 = *(const f32x4*)(p.in[11] + 8 * lane), g1 = *(const f32x4*)(p.in[11] + 8 * lane + 4);
    for (int row = blockIdx.x * 8 + w; row < NR; row += gridDim.x * 8) {
        f32x4 a[4], b[4]; u32x4 sgw[4];
#pragma unroll
        for (int h = 0; h < 4; ++h) { const u32x4 ow = *(const u32x4*)(OG + (size_t)row * D + h * 512 + 8 * lane);
            a[h][0] = bflo(ow.x); a[h][1] = bfhi(ow.x); a[h][2] = bflo(ow.y); a[h][3] = bfhi(ow.y); b[h][0] = bflo(ow.z); b[h][1] = bfhi(ow.z); b[h][2] = bflo(ow.w); b[h][3] = bfhi(ow.w);
            sgw[h] = *(const u32x4*)(P + (size_t)row * LDP + G_OFF + h * 512 + 8 * lane); }
#pragma unroll
        for (int h = 0; h < 4; ++h) {
            float ss = a[h][0] * a[h][0] + a[h][1] * a[h][1] + a[h][2] * a[h][2] + a[h][3] * a[h][3] + b[h][0] * b[h][0] + b[h][1] * b[h][1] + b[h][2] * b[h][2] + b[h][3] * b[h][3];
            ss = wave_sum(ss); const float rstd = rsqrtf(ss * (1.0f / 512.0f) + 1e-6f);
            float sg[8]; unpack8(sgw[h], sg);
            float y[8];
#pragma unroll
            for (int e = 0; e < 4; ++e) { y[e] = a[h][e] * rstd * g0[e] * sg[e]; y[4 + e] = b[h][e] * rstd * g1[e] * sg[4 + e]; }
            *(u32x4*)(Aa + (size_t)row * D + h * 512 + 8 * lane) = pack8(y); } }
}
template <bool FINAL>
__device__ __forceinline__ void phase_ln(const Params& p, const bf16_t* H, const float* gam, const float* bet) {
    const int tid = otid(), w = tid >> 6, lane = tid & 63;
    bf16_t* X1b = (bf16_t*)(p.ws + O_X1B);
    for (int row = blockIdx.x * 8 + w; row < NR; row += gridDim.x * 8) {
        u32x4 hw[4];
#pragma unroll
        for (int i = 0; i < 4; ++i) hw[i] = *(const u32x4*)(H + (size_t)row * D + 8 * (lane + 64 * i));
        float v[4][8]; float s = 0.f;
#pragma unroll
        for (int i = 0; i < 4; ++i) { unpack8(hw[i], v[i]);
#pragma unroll
            for (int e = 0; e < 8; ++e) s += v[i][e]; }
        const float mu = wave_sum(s) * (1.0f / 2048.0f);
        float q = 0.f;
#pragma unroll
        for (int i = 0; i < 4; ++i)
#pragma unroll
            for (int e = 0; e < 8; ++e) { v[i][e] -= mu; q += v[i][e] * v[i][e]; }
        const float rstd = rsqrtf(wave_sum(q) * (1.0f / 2048.0f) + 1e-5f);
        float* orow = row < NP ? p.out + OUT_YP + (size_t)row * D : p.out + OUT_YS + (size_t)(row - NP) * D;
#pragma unroll
        for (int i = 0; i < 4; ++i) { const int c = 8 * (lane + 64 * i);
            const f32x4 g0 = *(const f32x4*)(gam + c), g1 = *(const f32x4*)(gam + c + 4), b0 = *(const f32x4*)(bet + c), b1 = *(const f32x4*)(bet + c + 4);
            float y[8];
#pragma unroll
            for (int e = 0; e < 4; ++e) { y[e] = v[i][e] * rstd * g0[e] + b0[e]; y[4 + e] = v[i][4 + e] * rstd * g1[e] + b1[e]; }
            if (FINAL) { *(f32x4*)(orow + c) = (f32x4){y[0], y[1], y[2], y[3]}; *(f32x4*)(orow + c + 4) = (f32x4){y[4], y[5], y[6], y[7]}; }
            else *(u32x4*)(X1b + (size_t)row * D + c) = pack8(y); } }
}
__device__ __forceinline__ void phase_ffn_mid(const Params& p) {
    const bf16_t* HGU = (const bf16_t*)(p.ws + O_P); bf16_t* Af = (bf16_t*)(p.ws + O_OG);
    const float* wf = p.in[23]; const float* bf = p.in[24];
    const size_t stride = (size_t)gridDim.x * 512, t00 = (size_t)blockIdx.x * 512 + otid();
    for (size_t u = t00; u < (size_t)(NP / 16) * 688; u += stride) { const int rb = (int)(u / 688), seg = (int)(u - (size_t)rb * 688), c = 8 * seg, row0 = 16 * rb, t0 = row0 & 2047, b = row0 >> 11;
        float w0[8], w1[8], w2[8], bb[8];
        { const f32x4 a0 = *(const f32x4*)(wf + c), a1 = *(const f32x4*)(wf + c + 4), b0 = *(const f32x4*)(wf + DFF + c), b1 = *(const f32x4*)(wf + DFF + c + 4), c0 = *(const f32x4*)(wf + 2 * DFF + c), c1 = *(const f32x4*)(wf + 2 * DFF + c + 4), d0 = *(const f32x4*)(bf + c), d1 = *(const f32x4*)(bf + c + 4);
#pragma unroll
          for (int e = 0; e < 4; ++e) { w0[e] = a0[e]; w0[4 + e] = a1[e]; w1[e] = b0[e]; w1[4 + e] = b1[e]; w2[e] = c0[e]; w2[4 + e] = c1[e]; bb[e] = d0[e]; bb[4 + e] = d1[e]; } }
        const bf16_t* hb = HGU + (size_t)row0 * NGU + c;
        float h0[8], h1[8];
#pragma unroll
        for (int e = 0; e < 8; ++e) { h0[e] = 0.f; h1[e] = 0.f; }
        if (t0 >= 2) { unpack8(*(const u32x4*)(hb - 2 * NGU), h0); unpack8(*(const u32x4*)(hb - NGU), h1); }
        for (int r0 = 0; r0 < 16; r0 += 8) {
            u32x4 xg[8], xu[8];
#pragma unroll
            for (int i = 0; i < 8; ++i) { const bf16_t* hr = hb + (size_t)(r0 + i) * NGU; xg[i] = *(const u32x4*)hr; xu[i] = *(const u32x4*)(hr + DFF); }
#pragma unroll
            for (int i = 0; i < 8; ++i) { float h2[8], hu[8], y[8]; unpack8(xg[i], h2); unpack8(xu[i], hu);
#pragma unroll
                for (int e = 0; e < 8; ++e) { const float hc = w0[e] * h0[e] + w1[e] * h1[e] + w2[e] * h2[e] + bb[e]; y[e] = silu(hc) * hu[e]; h0[e] = h1[e]; h1[e] = h2[e]; }
                *(u32x4*)(Af + (size_t)(row0 + r0 + i) * DFF + c) = pack8(y);
                const int t = t0 + r0 + i;
                if (t >= 2046) { float* so = p.out + OUT_PFFN + (size_t)(b * 2 + (t - 2046)) * DFF + c;
#pragma unroll
                    for (int e = 0; e < 8; ++e) so[e] = h2[e]; } }
        }
    }
    for (size_t it = t00; it < (size_t)NS * 688; it += stride) { const int bs = (int)(it / 688), seg = (int)(it - (size_t)bs * 688), c = 8 * seg;
        const bf16_t* hrow = HGU + (size_t)(NP + bs) * NGU + c;
        float h0[8], h1[8], h2[8], hu[8], y[8];
        unpack8(*(const u32x4*)hrow, h2); unpack8(*(const u32x4*)(hrow + DFF), hu);
        const float* sc = p.in[7] + (size_t)bs * 2 * DFF + c; float* so = p.out + OUT_SFFN + (size_t)bs * 2 * DFF + c;
#pragma unroll
        for (int e = 0; e < 8; ++e) { h0[e] = sc[e]; h1[e] = sc[DFF + e]; so[e] = h1[e]; so[DFF + e] = h2[e]; }
#pragma unroll
        for (int e = 0; e < 8; ++e) { const float hc = wf[c + e] * h0[e] + wf[DFF + c + e] * h1[e] + wf[2 * DFF + c + e] * h2[e] + bf[c + e]; y[e] = silu(hc) * hu[e]; }
        *(u32x4*)(Af + (size_t)(NP + bs) * DFF + c) = pack8(y); }
}

__device__ __forceinline__ void samp_mma(f32x4 (&acc)[4][2], const bf16_t* A, int lda, const bf16_t* Bt, int K, int j) {
    const int tid = otid(), w = tid >> 6, lane = tid & 63, fr = lane & 15, fq = lane >> 4;
    const int KS = K / 32, cb = j >> 1, rh = j & 1;
    sk_zero(acc);
    sk_mma<4, 2, false, 4>(acc, A + (size_t)(NP + 64 * rh + fr) * lda + 8 * fq, (size_t)16 * lda, Bt + (size_t)(32 * cb + fr) * K + 8 * fq, (size_t)16 * K, (w * KS) >> 3, ((w + 1) * KS) >> 3);
}

__global__ __launch_bounds__(512, 2) void mega(Params p) {
    extern __shared__ __attribute__((aligned(16))) unsigned char shm[];
    cg::grid_group grid = cg::this_grid();
    PG8_LAS unsigned char* lds = (PG8_LAS unsigned char*)shm;
    unsigned char* ws = p.ws;
    const int G = gridDim.x, bid = blockIdx.x, tid = threadIdx.x;
    bf16_t* Xb = (bf16_t*)(ws + O_XB); bf16_t* P = (bf16_t*)(ws + O_P);
    pg8::StaticOrder S;
    volatile LAS unsigned* xst = (volatile LAS unsigned*)(shm + LDS_BYTES - 32);
    if (tid == 0) { xst[0] = 0u; xst[1] = 0u; }
    __syncthreads();
    const XcdBarrier xb = xcd_barrier_post((unsigned*)(ws + O_CTRL), xst);

    for (int rep = 0; rep < REP_P0; ++rep) phase_convert(p, shm);
    if (p.ws == nullptr) grid.sync();
    xcd_barrier(xb);

    { S.init(NP, NIN, G, bid, REP_P1); EpiInproj E{P};
      pg8::gemm_phase<EpiInproj, pg8::StaticOrder>(lds, pg8::Gemm{Xb, (const bf16_t*)(ws + O_WIN), NP, NIN, D}, S, E, nullptr); }
    __syncthreads();
    for (int rep = 0; rep < REP_SK; ++rep) {
    for (int j = bid; j < 512; j += G) p1_sample_inproj(p, shm, j);
    for (int j = bid; j < 512; j += G) p1_memkv(p, shm, j);
    for (int j = bid; j < 260; j += G) p1_alr(p, shm, j); }
    xcd_barrier(xb);

    for (int rep = 0; rep < REP_P2; ++rep)
    { int* sjob = (int*)(shm + LDS_BYTES - 64); unsigned* ctr = (unsigned*)(ws + O_CTRL) + 64 * rep;
      if (bid < 128) { const int xs = bid & 7, ms = bid >> 3, g = (2 * xs + (ms >> 3)) * 8 + (ms & 7);
          for (int r2 = 0; r2 < REP_GLA; ++r2) gla_prompt_job(p, shm, g); }
      for (;;) {
          __syncthreads();
          if (tid == 0) *sjob = (int)atomicAdd(ctr, 1u);
          __syncthreads();
          const int q = *sjob;
          if (q >= 961) break;
          int j;
          { const int t = q / 3, r = q - 3 * t; if (r == 2) j = 640 + t; else { j = 2 * t + r; if (j >= 640) j = 960; } }
          if (j < 512) gla_sample_job(p, shm, j);
          else if (j < 640) attn_sample_job(p, shm, j - 512);
          else if (j < 896) attn_prompt_job(p, j - 640);
          else conv_job(p, j - 896);
      } }
    xcd_barrier(xb);

    phase_gla_norm(p);
    xcd_barrier(xb);

    { float* MGf = (float*)(ws + O_MGF); bf16_t* MGb = (bf16_t*)(ws + O_MGB);
      const bf16_t* Aa = (const bf16_t*)(ws + O_AA); const bf16_t* Ab = (const bf16_t*)(ws + O_AB); const bf16_t* Am = (const bf16_t*)(ws + O_AM);
      const bf16_t* Wgo = (const bf16_t*)(ws + O_WGO); const bf16_t* Wco = (const bf16_t*)(ws + O_WCO); const bf16_t* Wmo = (const bf16_t*)(ws + O_WMO);
      S.init(NP, D, G, bid);
      { EpiMerge E{P, MGf, MGb, ZA_OFF, 0}; pg8::gemm_phase<EpiMerge, pg8::StaticOrder>(lds, pg8::Gemm{Aa, Wgo, NP, D, D}, S, E, nullptr); }
      { EpiMerge E{P, MGf, MGb, ZB_OFF, 1}; pg8::gemm_phase<EpiMerge, pg8::StaticOrder>(lds, pg8::Gemm{Ab, Wco, NP, D, 1024}, S, E, nullptr); }
      { EpiMerge E{P, MGf, MGb, ZM_OFF, 2}; pg8::gemm_phase<EpiMerge, pg8::StaticOrder>(lds, pg8::Gemm{Am, Wmo, NP, D, 1024}, S, E, nullptr); }
      for (int rep = 0; rep < REP_SK; ++rep)
      for (int j = bid; j < 128; j += G) { const int cb = j >> 1, rh = j & 1;
          f32x4 fin = (f32x4){0.f, 0.f, 0.f, 0.f};
#pragma unroll
          for (int br = 0; br < 3; ++br) { f32x4 acc[4][2];
              if (br == 0) samp_mma(acc, Aa, D, Wgo, D, j); else if (br == 1) samp_mma(acc, Ab, 1024, Wco, 1024, j); else samp_mma(acc, Am, 1024, Wmo, 1024, j);
              const int zoff = br == 0 ? ZA_OFF : br == 1 ? ZB_OFF : ZM_OFF;
              sk_reduce<8>(shm, &acc[0][0], [&](int, int t, int ln, f32x4 v) { const int rt = t >> 1, ct = t & 1, r = ln & 15, q = ln >> 4;
                  const u32x2 gw = *(const u32x2*)(P + (size_t)(NP + 64 * rh + 16 * rt + r) * LDP + zoff + 32 * cb + 16 * ct + 4 * q);
                  f32x4 g; g[0] = bflo(gw.x); g[1] = bfhi(gw.x); g[2] = bflo(gw.y); g[3] = bfhi(gw.y);
                  fin = fin + g * v; }); }
          { const int s2 = otid(), t = s2 >> 6, ln = s2 & 63, rt = t >> 1, ct = t & 1, r = ln & 15, q = ln >> 4;
              u32x2 o; o.x = pk2(fin[0], fin[1]); o.y = pk2(fin[2], fin[3]);
              *(u32x2*)(MGb + (size_t)(NP + 64 * rh + 16 * rt + r) * D + 32 * cb + 16 * ct + 4 * q) = o; } } }
    xcd_barrier(xb);

    { const bf16_t* MGb = (const bf16_t*)(ws + O_MGB); const bf16_t* Wo = (const bf16_t*)(ws + O_WO); bf16_t* H1 = (bf16_t*)(ws + O_H1);
      S.init(NP, D, G, bid);
      { EpiResidB E{Xb, H1}; pg8::gemm_phase<EpiResidB, pg8::StaticOrder>(lds, pg8::Gemm{MGb, Wo, NP, D, D}, S, E, nullptr); }
      for (int rep = 0; rep < REP_SK; ++rep)
      for (int j = bid; j < 128; j += G) { f32x4 acc[4][2]; samp_mma(acc, MGb, D, Wo, D, j); const float* xs = p.in[1]; const int cb = j >> 1, rh = j & 1;
          sk_reduce<8>(shm, &acc[0][0], [&](int, int t, int ln, f32x4 v) { const int rt = t >> 1, ct = t & 1, r = 64 * rh + 16 * rt + (ln & 15), col = 32 * cb + 16 * ct + 4 * (ln >> 4);
              const f32x4 y = *(const f32x4*)(xs + (size_t)r * D + col) * DN_ALPHA + v;
              u32x2 w; w.x = pk2(y[0], y[1]); w.y = pk2(y[2], y[3]); *(u32x2*)(H1 + (size_t)(NP + r) * D + col) = w; }); } }
    xcd_barrier(xb);

    phase_ln<false>(p, (const bf16_t*)(ws + O_H1), p.in[19], p.in[20]);
    xcd_barrier(xb);

    { S.init(NRP, NGU, G, bid, REP_P6); EpiBf16 E{P, NGU};
      pg8::gemm_phase<EpiBf16, pg8::StaticOrder>(lds, pg8::Gemm{(const bf16_t*)(ws + O_X1B), (const bf16_t*)(ws + O_WGU), NRP, NGU, D}, S, E, nullptr); }
    xcd_barrier(xb);

    for (int rep = 0; rep < REP_P7; ++rep) phase_ffn_mid(p);
    xcd_barrier(xb);

    { const bf16_t* Af = (const bf16_t*)(ws + O_OG); const bf16_t* Wd = (const bf16_t*)(ws + O_WD); const bf16_t* X1r = (const bf16_t*)(ws + O_X1B); bf16_t* H2 = (bf16_t*)(ws + O_H1);
      S.init(NP, D, G, bid);
      { EpiResidB E{X1r, H2}; pg8::gemm_phase<EpiResidB, pg8::StaticOrder>(lds, pg8::Gemm{Af, Wd, NP, D, DFF}, S, E, nullptr); }
      for (int rep = 0; rep < REP_SK; ++rep)
      for (int j = bid; j < 128; j += G) { f32x4 acc[4][2]; samp_mma(acc, Af, DFF, Wd, DFF, j); const int cb = j >> 1, rh = j & 1;
          sk_reduce<8>(shm, &acc[0][0], [&](int, int t, int ln, f32x4 v) { const int rt = t >> 1, ct = t & 1;
              const size_t o = (size_t)(NP + 64 * rh + 16 * rt + (ln & 15)) * D + 32 * cb + 16 * ct + 4 * (ln >> 4);
              const u32x2 rw = *(const u32x2*)(X1r + o); f32x4 r; r[0] = bflo(rw.x); r[1] = bfhi(rw.x); r[2] = bflo(rw.y); r[3] = bfhi(rw.y);
              const f32x4 y = r * DN_ALPHA + v; u32x2 w; w.x = pk2(y[0], y[1]); w.y = pk2(y[2], y[3]); *(u32x2*)(H2 + o) = w; }); } }
    xcd_barrier(xb);

    for (int rep = 1; rep < REP_SYNC; ++rep) xcd_barrier(xb);
    phase_ln<true>(p, (const bf16_t*)(ws + O_H1), p.in[26], p.in[27]);
}

extern "C" void kernel_launch(void* const* d_in, const int* in_sizes, int n_in, void* d_out, int out_size, void* d_ws, size_t ws_size, hipStream_t stream) {
    static int grid_blocks = 0;
    if (!grid_blocks) {
        int dev = 0, cus = 0, per_cu = 0;
        (void)hipGetDevice(&dev);
        (void)hipDeviceGetAttribute(&cus, hipDeviceAttributeMultiprocessorCount, dev);
        (void)hipFuncSetAttribute((const void*)mega, hipFuncAttributeMaxDynamicSharedMemorySize, LDS_BYTES);
        (void)hipOccupancyMaxActiveBlocksPerMultiprocessor(&per_cu, mega, 512, LDS_BYTES);
        if (per_cu > 1) per_cu = 1;
        grid_blocks = cus * per_cu;
        if (grid_blocks <= 0) { fprintf(stderr, "occupancy query returned 0 (cus %d per_cu %d)\n", cus, per_cu); grid_blocks = cus > 0 ? cus : 256; }
    }
    Params p; memset(&p, 0, sizeof(p));
    for (int i = 0; i < 28; ++i) p.in[i] = (const float*)d_in[i];
    p.out = (float*)d_out; p.ws = (unsigned char*)d_ws;
    unsigned char* ws = (unsigned char*)d_ws;
    (void)hipMemsetAsync(ws + O_CTRL, 0, 16384, stream);
    void* args[] = {&p};
    hipError_t e = hipLaunchCooperativeKernel((const void*)mega, dim3(grid_blocks), dim3(512), args, LDS_BYTES, stream);
    if (e != hipSuccess) fprintf(stderr, "cooperative launch failed: %s (grid %d)\n", hipGetErrorString(e), grid_blocks);
}
```
